# Optimizing an MI355X kernel written in HIP

```python
import math
import jax, jax.numpy as jnp
from jax import lax
import numpy as np

D_MODEL = 1024
BATCH = 4
SEQ = 4096
DEPTH = 4

ROPE_THETA = 10000.0
QBLK = 128
MLA_HEADS = 8
MLA_NOPE = 64
MLA_ROPE = 32
MLA_V = 64
MLA_Q_RANK = 256
MLA_KV_RANK = 128
FOX_HEADS = 8
FOX_DIM = 64
SWA_HEADS = 16
SWA_KV_HEADS = 2
SWA_DIM = 64
WINDOW = 128

RMS_EPS = 1e-6
LN_EPS = 1e-5
ALPHA = (2 * DEPTH) ** 0.25
BETA = (8 * DEPTH) ** -0.25

EVEN_WIDTH = MLA_HEADS * MLA_V + FOX_HEADS * FOX_DIM
ODD_WIDTH = SWA_HEADS * SWA_DIM
EVEN_SIZES = (MLA_Q_RANK, MLA_KV_RANK, MLA_ROPE, FOX_HEADS * FOX_DIM,
              FOX_HEADS * FOX_DIM, FOX_HEADS * FOX_DIM, FOX_HEADS, EVEN_WIDTH)
EVEN_IN = sum(EVEN_SIZES)
EVEN_V_START = MLA_Q_RANK + MLA_KV_RANK + MLA_ROPE + 2 * FOX_HEADS * FOX_DIM
ODD_SIZES = (SWA_HEADS * SWA_DIM, SWA_KV_HEADS * SWA_DIM, SWA_KV_HEADS * SWA_DIM, ODD_WIDTH)
ODD_IN = sum(ODD_SIZES)
ODD_V_START = SWA_HEADS * SWA_DIM + SWA_KV_HEADS * SWA_DIM
N_EVEN = (DEPTH + 1) // 2
N_ODD = DEPTH // 2

kernel_name = "hybrid_mla_fox_swa_deepnorm"


def _split(h, sizes):
    cuts = [int(c) for c in np.cumsum(sizes)[:-1]]
    return jnp.split(h, cuts, axis=-1)


def _heads(t, n_heads):
    b, s, _ = t.shape
    return t.reshape(b, s, n_heads, -1).transpose(0, 2, 1, 3)


def _merge(t):
    b, h, s, d = t.shape
    return t.transpose(0, 2, 1, 3).reshape(b, s, h * d)


def rms_norm(t, g):
    tf = t.astype(jnp.float32)
    tf = tf * lax.rsqrt(jnp.mean(tf * tf, axis=-1, keepdims=True) + RMS_EPS)
    return (tf * g.astype(jnp.float32)).astype(t.dtype)


def layer_norm(t, g, b):
    tf = t.astype(jnp.float32)
    mu = jnp.mean(tf, axis=-1, keepdims=True)
    var = jnp.mean(jnp.square(tf - mu), axis=-1, keepdims=True)
    y = (tf - mu) * lax.rsqrt(var + LN_EPS) * g.astype(jnp.float32) + b.astype(jnp.float32)
    return y.astype(t.dtype)


def rope(t, pos):
    d = t.shape[-1]
    inv = ROPE_THETA ** (-jnp.arange(0, d, 2, dtype=jnp.float32) / d)
    ang = pos.astype(jnp.float32)[:, None] * inv[None, :]
    cos, sin = jnp.cos(ang), jnp.sin(ang)
    t1, t2 = jnp.split(t.astype(jnp.float32), 2, axis=-1)
    return jnp.concatenate([t1 * cos - t2 * sin, t2 * cos + t1 * sin], axis=-1).astype(t.dtype)


def causal_block_attention(q, k, v, scale, cum_logf=None):
    b, h, s, dk = q.shape
    dv = v.shape[-1]
    nb = s // QBLK
    qb = q.reshape(b, h, nb, QBLK, dk).transpose(2, 0, 1, 3, 4)
    kpos = jnp.arange(s)
    idx = jnp.arange(nb)

    def block(args):
        if cum_logf is None:
            q_i, i = args
        else:
            q_i, c_i, i = args
        sc = jnp.einsum('bhqd,bhkd->bhqk', q_i, k,
                        preferred_element_type=jnp.float32) * scale
        if cum_logf is not None:
            sc = sc + c_i[..., :, None] - cum_logf[..., None, :]
        qpos = i * QBLK + jnp.arange(QBLK)
        mask = kpos[None, :] <= qpos[:, None]
        sc = jnp.where(mask, sc, -jnp.inf)
        p = jax.nn.softmax(sc, axis=-1)
        return jnp.einsum('bhqk,bhkd->bhqd', p.astype(v.dtype), v)

    if cum_logf is None:
        xs = (qb, idx)
    else:
        cb = cum_logf.reshape(b, h, nb, QBLK).transpose(2, 0, 1, 3)
        xs = (qb, cb, idx)
    out = lax.map(block, xs)
    return out.transpose(1, 2, 0, 3, 4).reshape(b, h, s, dv)


def sliding_window_sink_attention(q, k, v, sinks):
    b, h, s, d = q.shape
    hkv = k.shape[1]
    g = h // hkv
    nb = s // QBLK
    scale = d ** -0.5
    qb = q.reshape(b, hkv, g, nb, QBLK, d).transpose(3, 0, 1, 2, 4, 5)
    pad = ((0, 0), (0, 0), (QBLK, 0), (0, 0))
    kp = jnp.pad(k, pad)
    vp = jnp.pad(v, pad)
    sink = sinks.astype(jnp.float32).reshape(1, hkv, g, 1, 1)

    def block(args):
        q_i, i = args
        start = i * QBLK
        k_i = lax.dynamic_slice_in_dim(kp, start, 2 * QBLK, axis=2)
        v_i = lax.dynamic_slice_in_dim(vp, start, 2 * QBLK, axis=2)
        sc = jnp.einsum('bkgqd,bkjd->bkgqj', q_i, k_i,
                        preferred_element_type=jnp.float32) * scale
        qpos = start + jnp.arange(QBLK)
        kpos = start - QBLK + jnp.arange(2 * QBLK)
        diff = qpos[:, None] - kpos[None, :]
        mask = (diff >= 0) & (diff < WINDOW) & (kpos[None, :] >= 0)
        sc = jnp.where(mask, sc, -jnp.inf)
        logits = jnp.concatenate(
            [sc, jnp.broadcast_to(sink, sc.shape[:-1] + (1,))], axis=-1)
        p = jax.nn.softmax(logits, axis=-1)[..., :-1]
        return jnp.einsum('bkgqj,bkjd->bkgqd', p.astype(v.dtype), v_i)

    out = lax.map(block, (qb, jnp.arange(nb)))
    return out.transpose(1, 2, 3, 0, 4, 5).reshape(b, h, s, d)


def even_mixer(x, w_in, q_norm, w_uq, kv_norm, w_ukv, b_f, w_out, pos):
    b, s, _ = x.shape
    h = x @ w_in
    cq, ckv, k_pe, fq, fk, fv, f_logit, gate = _split(h, EVEN_SIZES)
    q = (rms_norm(cq, q_norm) @ w_uq).reshape(b, s, MLA_HEADS, MLA_NOPE + MLA_ROPE)
    q = q.transpose(0, 2, 1, 3)
    q_nope, q_pe = q[..., :MLA_NOPE], rope(q[..., MLA_NOPE:], pos)
    kv = (rms_norm(ckv, kv_norm) @ w_ukv).reshape(b, s, MLA_HEADS, MLA_NOPE + MLA_V)
    kv = kv.transpose(0, 2, 1, 3)
    k_nope, v_mla = kv[..., :MLA_NOPE], kv[..., MLA_NOPE:]
    k_pe = rope(k_pe[:, None], pos)
    q_mla = jnp.concatenate([q_nope, q_pe], axis=-1)
    k_mla = jnp.concatenate(
        [k_nope, jnp.broadcast_to(k_pe, (b, MLA_HEADS, s, MLA_ROPE))], axis=-1)
    o_mla = causal_block_attention(q_mla, k_mla, v_mla, (MLA_NOPE + MLA_ROPE) ** -0.5)
    log_f = jax.nn.log_sigmoid((f_logit + b_f).astype(jnp.float32))
    cum = lax.cumsum(log_f, axis=1).transpose(0, 2, 1)
    o_fox = causal_block_attention(_heads(fq, FOX_HEADS), _heads(fk, FOX_HEADS),
                                   _heads(fv, FOX_HEADS), FOX_DIM ** -0.5, cum)
    o = jnp.concatenate([_merge(o_mla), _merge(o_fox)], axis=-1)
    return (o * jax.nn.silu(gate)) @ w_out


def odd_mixer(x, w_in, sinks, w_out, pos):
    h = x @ w_in
    q, k, v, gate = _split(h, ODD_SIZES)
    q = rope(_heads(q, SWA_HEADS), pos)
    k = rope(_heads(k, SWA_KV_HEADS), pos)
    v = _heads(v, SWA_KV_HEADS)
    o = _merge(sliding_window_sink_attention(q, k, v, sinks))
    return (o * jax.nn.silu(gate)) @ w_out


def setup_inputs(seed: int = 0) -> dict:
    key = jax.random.key(seed)
    ks = jax.random.split(key, 16)
    nrm = jax.random.normal
    even_in_scale = jnp.ones((EVEN_IN,), jnp.float32).at[
        EVEN_V_START:EVEN_V_START + FOX_HEADS * FOX_DIM].set(BETA)
    ukv_scale = jnp.tile(jnp.concatenate([jnp.ones((MLA_NOPE,), jnp.float32),
                                          jnp.full((MLA_V,), BETA, jnp.float32)]), MLA_HEADS)
    odd_in_scale = jnp.ones((ODD_IN,), jnp.float32).at[
        ODD_V_START:ODD_V_START + SWA_KV_HEADS * SWA_DIM].set(BETA)
    return {
        "x": nrm(ks[0], (BATCH, SEQ, D_MODEL), jnp.float32),
        "even_w_in": nrm(ks[1], (N_EVEN, D_MODEL, EVEN_IN), jnp.float32) * D_MODEL ** -0.5 * even_in_scale,
        "even_q_norm": 1.0 + 0.02 * nrm(ks[2], (N_EVEN, MLA_Q_RANK), jnp.float32),
        "even_w_uq": nrm(ks[3], (N_EVEN, MLA_Q_RANK, MLA_HEADS * (MLA_NOPE + MLA_ROPE)), jnp.float32) * MLA_Q_RANK ** -0.5,
        "even_kv_norm": 1.0 + 0.02 * nrm(ks[4], (N_EVEN, MLA_KV_RANK), jnp.float32),
        "even_w_ukv": nrm(ks[5], (N_EVEN, MLA_KV_RANK, MLA_HEADS * (MLA_NOPE + MLA_V)), jnp.float32) * MLA_KV_RANK ** -0.5 * ukv_scale,
        "even_b_f": jax.random.uniform(ks[6], (N_EVEN, FOX_HEADS), jnp.float32, 1.0, 6.0),
        "even_w_out": nrm(ks[7], (N_EVEN, EVEN_WIDTH, D_MODEL), jnp.float32) * EVEN_WIDTH ** -0.5 * BETA,
        "even_ln_g": 1.0 + 0.02 * nrm(ks[8], (N_EVEN, D_MODEL), jnp.float32),
        "even_ln_b": 0.02 * nrm(ks[9], (N_EVEN, D_MODEL), jnp.float32),
        "odd_w_in": nrm(ks[10], (N_ODD, D_MODEL, ODD_IN), jnp.float32) * D_MODEL ** -0.5 * odd_in_scale,
        "odd_sinks": 0.5 * nrm(ks[11], (N_ODD, SWA_HEADS), jnp.float32),
        "odd_w_out": nrm(ks[12], (N_ODD, ODD_WIDTH, D_MODEL), jnp.float32) * ODD_WIDTH ** -0.5 * BETA,
        "odd_ln_g": 1.0 + 0.02 * nrm(ks[13], (N_ODD, D_MODEL), jnp.float32),
        "odd_ln_b": 0.02 * nrm(ks[14], (N_ODD, D_MODEL), jnp.float32),
    }


def reference(x, even_w_in, even_q_norm, even_w_uq, even_kv_norm, even_w_ukv, even_b_f,
              even_w_out, even_ln_g, even_ln_b, odd_w_in, odd_sinks, odd_w_out,
              odd_ln_g, odd_ln_b):
    pos = jnp.arange(x.shape[1])
    for layer in range(DEPTH):
        j = layer // 2
        if layer % 2 == 0:
            y = even_mixer(x, even_w_in[j], even_q_norm[j], even_w_uq[j], even_kv_norm[j],
                           even_w_ukv[j], even_b_f[j], even_w_out[j], pos)
            x = layer_norm(ALPHA * x + y, even_ln_g[j], even_ln_b[j])
        else:
            y = odd_mixer(x, odd_w_in[j], odd_sinks[j], odd_w_out[j], pos)
            x = layer_norm(ALPHA * x + y, odd_ln_g[j], odd_ln_b[j])
    return x
```

```cpp
#include <hip/hip_runtime.h>
#include <cstdio>
#include <cstdint>

#ifndef MK_N_LAUNCHES
#define MK_N_LAUNCHES 19
#endif

#define LAS __attribute__((address_space(3)))
typedef unsigned short bf16_t;
typedef short bf16x8 __attribute__((ext_vector_type(8)));
typedef short s16x4 __attribute__((ext_vector_type(4)));
typedef float f32x4 __attribute__((ext_vector_type(4)));
typedef float f32x2 __attribute__((ext_vector_type(2)));
typedef float f32x16 __attribute__((ext_vector_type(16)));
typedef unsigned u32x4 __attribute__((ext_vector_type(4)));
typedef unsigned u32x2 __attribute__((ext_vector_type(2)));

constexpr int NWAVES = 8;
constexpr int MTOK = 16384, DMODEL = 1024, SEQ = 4096, NBATCH = 4, DEPTH = 4;
constexpr int EVEN_IN = 2984, EVEN_INP = 3072, ODD_IN = 2304;
constexpr float RMS_EPS = 1e-6f, LN_EPS = 1e-5f;
constexpr float ALPHA = 1.6817928305074290f;
constexpr float LOG2E = 1.4426950408889634f;
constexpr float SC_MLA = 0.10206207261596575f * LOG2E;
constexpr float SC_64 = 0.125f * LOG2E;

constexpr size_t MiB = 1u << 20;
constexpr size_t WS_CTL = 0, CTL_ZERO_BYTES = 1 * MiB;
constexpr size_t WS_TABS = 1 * MiB;
constexpr size_t WS_TABM = 2 * MiB;
constexpr size_t WS_LOGF = 2 * MiB + 512 * 1024;
constexpr size_t WS_CUM = 3 * MiB;
constexpr size_t WS_SSQ = 3 * MiB + 512 * 1024;
constexpr size_t WS_W = 4 * MiB;
constexpr size_t W_INE = 0, W_UP = 6 * MiB, W_OUTE = 7 * MiB, W_INO = 9 * MiB, W_OUTO = 14 * MiB, W_LAYER = 16 * MiB;
constexpr size_t WS_XB = 36 * MiB;
constexpr size_t WS_G = 68 * MiB;
constexpr size_t WS_HA = 100 * MiB;
constexpr size_t WS_QM = 116 * MiB;
constexpr size_t WS_KM = 140 * MiB;
constexpr size_t WS_VM = 164 * MiB;
constexpr size_t WS_FQ = 180 * MiB, WS_FK = 196 * MiB, WS_FV = 212 * MiB;
constexpr size_t WS_QS = 116 * MiB;
constexpr size_t WS_KS = 148 * MiB, WS_VS = 152 * MiB;
constexpr size_t WS_END = 228 * MiB;

constexpr int RING_BYTES = 131072;
constexpr int LDS_BYTES = 147456;

__device__ __forceinline__ unsigned cvt_pk_bf16(float lo, float hi) { unsigned r; asm volatile("v_cvt_pk_bf16_f32 %0, %1, %2" : "=v"(r) : "v"(lo), "v"(hi)); return r; }
__device__ __forceinline__ float bf_lo(unsigned w) { return __uint_as_float(w << 16); }
__device__ __forceinline__ float bf_hi(unsigned w) { return __uint_as_float(w & 0xffff0000u); }
__device__ __forceinline__ u32x4 pack8(f32x4 a, f32x4 b) { u32x4 w; w.x = cvt_pk_bf16(a[0], a[1]); w.y = cvt_pk_bf16(a[2], a[3]); w.z = cvt_pk_bf16(b[0], b[1]); w.w = cvt_pk_bf16(b[2], b[3]); return w; }
__device__ __forceinline__ float silu_f(float g) { return g * __builtin_amdgcn_rcpf(1.0f + __expf(-g)); }
__device__ __forceinline__ float logsigmoid_f(float v) { return fminf(v, 0.f) - log1pf(__expf(-fabsf(v))); }
__device__ __forceinline__ float shx(float v, int mask, int lane) { return __int_as_float(__builtin_amdgcn_ds_bpermute((lane ^ mask) << 2, __float_as_int(v))); }
__device__ __forceinline__ float swap32_max(float v) { auto rr = __builtin_amdgcn_permlane32_swap(__float_as_uint(v), __float_as_uint(v), false, false); return fmaxf(__uint_as_float(rr[0]), __uint_as_float(rr[1])); }
__device__ __forceinline__ float swap32_add(float v) { auto rr = __builtin_amdgcn_permlane32_swap(__float_as_uint(v), __float_as_uint(v), false, false); return __uint_as_float(rr[0]) + __uint_as_float(rr[1]); }
#define LDS_WAIT() asm volatile("s_waitcnt lgkmcnt(0)" ::: "memory")
#define VM_WAIT() asm volatile("s_waitcnt vmcnt(0)" ::: "memory")
__device__ __forceinline__ void rope8(f32x4& v0, f32x4& v1, const f32x4 c0, const f32x4 c1) {
    const float a0 = v0[0], b0 = v0[1], a1 = v0[2], b1 = v0[3], a2 = v1[0], b2 = v1[1], a3 = v1[2], b3 = v1[3];
    v0[0] = a0 * c0[0] - b0 * c0[1]; v0[1] = b0 * c0[0] + a0 * c0[1];
    v0[2] = a1 * c0[2] - b1 * c0[3]; v0[3] = b1 * c0[2] + a1 * c0[3];
    v1[0] = a2 * c1[0] - b2 * c1[1]; v1[1] = b2 * c1[0] + a2 * c1[1];
    v1[2] = a3 * c1[2] - b3 * c1[3]; v1[3] = b3 * c1[2] + a3 * c1[3];
}

namespace pg8 {
constexpr int BM = 256, BK = 64, HALF = 128, HTB = HALF * BK * 2, STAGE_BYTES = 8 * HTB, NXCD = 8, WGM = 8;
__host__ __device__ __forceinline__ int lds_byte(int r, int c) { const int st = (r >> 4) * 2 + (c >> 5), rr = r & 15, cc = c & 31, ob = rr * 64 + cc * 2; return st * 1024 + (ob ^ (((ob >> 9) & 1) << 5)); }
__host__ __device__ __forceinline__ void stage_rc(int b, int& R, int& C) { const int st = b / 1024, sb = b % 1024, swz = sb ^ (((sb >> 9) & 1) << 5); R = (st >> 1) * 16 + swz / 64; C = (st & 1) * 32 + (swz % 64) / 2; }
__host__ __device__ __forceinline__ int perm32(int rho) { const int n = rho >> 4, i = rho & 15; return 8 * (i >> 2) + 4 * n + (i & 3); }

struct Unit { int pm, pn; };
struct Gemm { const bf16_t* A; const bf16_t* Bt; int M, N, K, lda, split_pn, split_off; };

struct StaticOrder {
    int nM, nN, nwg, G, c;
    __host__ __device__ void init(int M, int N, int G_, int c_) { nM = M / BM; nN = N / BM; nwg = nM * nN; G = G_; c = c_; }
    __host__ __device__ bool next(int i, Unit& u) const {
        const long L = (long)i * G + c; if (L >= nwg) return false;
        int wgid = (int)L; { const int q = nwg / NXCD, r = nwg % NXCD, xcd = wgid % NXCD, off = wgid / NXCD; wgid = (xcd < r ? xcd * (q + 1) : r * (q + 1) + (xcd - r) * q) + off; }
        const int nig = WGM * nN, gid = wgid / nig, fm = gid * WGM, gsz = (nM - fm) < WGM ? (nM - fm) : WGM;
        u.pm = fm + ((wgid % nig) % gsz); u.pn = (wgid % nig) / gsz; return true;
    }
};

template <class Epi, bool ALIGN_EPI>
__device__ __forceinline__ void gemm_phase(LAS unsigned char* lds, const Gemm g, const StaticOrder& S, const Epi& E) {
    int tid_ = threadIdx.x; asm volatile("" : "+v"(tid_));
    const int tid = tid_, wid = __builtin_amdgcn_readfirstlane(tid >> 6), lane = tid & 63, wr = wid >> 2, wc = wid & 3, fr = lane & 15, fq = lane >> 4;
    const int K = g.K, nt = K / BK, lda = g.lda;
    unsigned voffA[2], voffB[2];
#pragma unroll
    for (int i = 0; i < 2; ++i) { int R, C; stage_rc(tid * 16 + i * 8192, R, C); const int Rb = Epi::PERM ? ((R & ~31) + perm32(R & 31)) : R;
        voffA[i] = (unsigned)(R * lda + C) * 2u; voffB[i] = (unsigned)(Rb * K + C) * 2u; }
    const size_t kstep = (size_t)(BK * 2);
    const size_t hstepA = (size_t)HALF * lda * 2, hstepB = (size_t)HALF * K * 2;
    const size_t tstepA = 2 * hstepA, tstepB = 2 * hstepB;
    const unsigned ldsw = (unsigned)wid * 1024u;
    const int aoff = lds_byte(wr * 64 + fr, fq * 8), boff = lds_byte(wc * 32 + fr, fq * 8);
#define PG8_SA(b, h) (((b) * 2 + (h)) * HTB)
#define PG8_SB(b, h) ((4 + (b) * 2 + (h)) * HTB)
#define PG8_STAGE(bufoff, gbase, voff) do { _Pragma("unroll") for (int _i = 0; _i < 2; ++_i) \
        __builtin_amdgcn_global_load_lds((const unsigned*)((const char*)(gbase) + (voff)[_i]), (LAS unsigned*)(lds + (bufoff) + ldsw + _i * 8192), 16, 0, 0); } while (0)
#define PG8_LDA(dst, b, h) do { _Pragma("unroll") for (int m = 0; m < 4; ++m) _Pragma("unroll") for (int k = 0; k < 2; ++k) dst[m][k] = *(const LAS bf16x8*)(lds + PG8_SA(b, h) + aoff + m * 2048 + k * 1024); } while (0)
#define PG8_LDB(dst, b, h) do { _Pragma("unroll") for (int n = 0; n < 2; ++n) _Pragma("unroll") for (int k = 0; k < 2; ++k) dst[n][k] = *(const LAS bf16x8*)(lds + PG8_SB(b, h) + boff + n * 2048 + k * 1024); } while (0)
#define PG8_MMA(ai, bj, At, Bt) do { __builtin_amdgcn_s_setprio(1); _Pragma("unroll") for (int m = 0; m < 4; ++m) _Pragma("unroll") for (int n = 0; n < 2; ++n) _Pragma("unroll") for (int k = 0; k < 2; ++k) \
        acc[ai][bj][m][n] = __builtin_amdgcn_mfma_f32_16x16x32_bf16(Bt[n][k], At[m][k], acc[ai][bj][m][n], 0, 0, 0); __builtin_amdgcn_s_setprio(0); } while (0)
#define PG8_WAIT_V(n) asm volatile("s_waitcnt vmcnt(" #n ")" ::: "memory")
#define PG8_WAIT_L(n) asm volatile("s_waitcnt lgkmcnt(" #n ")" ::: "memory")
#define PG8_BAR __builtin_amdgcn_s_barrier()
#define PG8_SCHED __builtin_amdgcn_sched_barrier(0)
#define PG8_APTR(u) ((const char*)g.A + (size_t)(u).pm * tstepA + ((u).pn >= g.split_pn ? (size_t)g.split_off * 2 : (size_t)0))
    Unit cur, nxt; int ui = 0;
    if (!S.next(0, cur)) return;
    f32x4 acc[2][2][4][2];
#pragma unroll
    for (int a = 0; a < 2; ++a)
#pragma unroll
        for (int b = 0; b < 2; ++b)
#pragma unroll
            for (int m = 0; m < 4; ++m)
#pragma unroll
                for (int n = 0; n < 2; ++n) acc[a][b][m][n] = (f32x4){0.f, 0.f, 0.f, 0.f};
    bf16x8 At[4][2], B0[2][2], B1[2][2];
    const char* cA = PG8_APTR(cur); const char* cB = (const char*)g.Bt + (size_t)cur.pn * tstepB;
    PG8_STAGE(PG8_SB(0, 0), cB, voffB); PG8_STAGE(PG8_SB(0, 1), cB + hstepB, voffB); PG8_STAGE(PG8_SA(0, 0), cA, voffA); PG8_STAGE(PG8_SA(0, 1), cA + hstepA, voffA);
    if (wr == 1) PG8_BAR;
    PG8_WAIT_V(2); PG8_BAR;
    PG8_STAGE(PG8_SB(1, 0), cB + kstep, voffB); PG8_STAGE(PG8_SA(1, 0), cA + kstep, voffA); PG8_STAGE(PG8_SB(1, 1), cB + hstepB + kstep, voffB);
    PG8_WAIT_V(6); PG8_BAR;
    for (;;) {
        const bool has_next = S.next(ui + 1, nxt);
        const char* nA = has_next ? PG8_APTR(nxt) : cA; const char* nB = has_next ? (const char*)g.Bt + (size_t)nxt.pn * tstepB : cB;
#pragma nounroll
        for (int t = 0; t < nt; t += 2) {
            const bool last = (t == nt - 2);
            const char* a1 = cA + (size_t)(t + 1) * kstep;
            const char* a2 = last ? nA : cA + (size_t)(t + 2) * kstep; const char* b2 = last ? nB : cB + (size_t)(t + 2) * kstep;
            const char* a3 = a2 + kstep; const char* b3 = b2 + kstep;
            PG8_LDB(B0, 0, 0); PG8_LDB(B1, 0, 1); PG8_SCHED; PG8_LDA(At, 0, 0); PG8_STAGE(PG8_SA(1, 1), a1 + hstepA, voffA);
            PG8_WAIT_V(8); PG8_WAIT_L(0); PG8_BAR; PG8_MMA(0, 0, At, B0); PG8_MMA(0, 1, At, B1); PG8_BAR; PG8_SCHED;
            PG8_LDA(At, 0, 1); PG8_STAGE(PG8_SB(0, 0), b2, voffB); PG8_STAGE(PG8_SB(0, 1), b2 + hstepB, voffB); PG8_STAGE(PG8_SA(0, 0), a2, voffA);
            PG8_WAIT_V(8); PG8_WAIT_L(0); PG8_BAR; PG8_MMA(1, 0, At, B0); PG8_MMA(1, 1, At, B1); PG8_BAR; PG8_SCHED;
            PG8_LDB(B0, 1, 0); PG8_LDB(B1, 1, 1); PG8_SCHED; PG8_LDA(At, 1, 0); PG8_STAGE(PG8_SA(0, 1), a2 + hstepA, voffA);
            PG8_WAIT_V(8); PG8_WAIT_L(0); PG8_BAR; PG8_MMA(0, 0, At, B0); PG8_MMA(0, 1, At, B1); PG8_BAR; PG8_SCHED;
            PG8_LDA(At, 1, 1); PG8_STAGE(PG8_SB(1, 0), b3, voffB); PG8_STAGE(PG8_SB(1, 1), b3 + hstepB, voffB); PG8_STAGE(PG8_SA(1, 0), a3, voffA);
            PG8_WAIT_V(8); PG8_WAIT_L(0); PG8_BAR; PG8_MMA(1, 0, At, B0); PG8_MMA(1, 1, At, B1); PG8_BAR; PG8_SCHED;
        }
        if constexpr (ALIGN_EPI) { if (wr == 0) PG8_BAR; }
        if constexpr (!Epi::AFTER_DRAIN) { E(acc, cur, wr, wc, fr, fq); }
        if (!has_next) break;
#pragma unroll
        for (int a = 0; a < 2; ++a)
#pragma unroll
            for (int b = 0; b < 2; ++b)
#pragma unroll
                for (int m = 0; m < 4; ++m)
#pragma unroll
                    for (int n = 0; n < 2; ++n) acc[a][b][m][n] = (f32x4){0.f, 0.f, 0.f, 0.f};
        cur = nxt; cA = nA; cB = nB; ++ui;
        if constexpr (ALIGN_EPI) { if (wr == 1) PG8_BAR; }
    }
    PG8_WAIT_V(0);
    if constexpr (!ALIGN_EPI) { if (wr == 0) PG8_BAR; }
    PG8_BAR;
    if constexpr (Epi::AFTER_DRAIN) { E.fused(acc, cur, wr, wc, fr, fq, lds, wid, lane); }
#undef PG8_SA
#undef PG8_SB
#undef PG8_STAGE
#undef PG8_LDA
#undef PG8_LDB
#undef PG8_MMA
#undef PG8_WAIT_V
#undef PG8_WAIT_L
#undef PG8_BAR
#undef PG8_SCHED
#undef PG8_APTR
}

typedef const f32x4 (&AccT)[2][2][4][2];

struct EpiEvenIn {
    static constexpr bool PERM = true, AFTER_DRAIN = false;
    bf16_t *HA, *KM, *FQ, *FK, *FV, *G; float *SSQ, *LOGF; const float* b_f; const float* tabM;
    __device__ __forceinline__ void operator()(AccT acc, const Unit& u, int wr, int wc, int fr, int fq) const {
        const int pn = u.pn;
#pragma unroll
        for (int ai = 0; ai < 2; ++ai)
#pragma unroll
            for (int m = 0; m < 4; ++m) {
                const int row = u.pm * BM + ai * HALF + wr * 64 + m * 16 + fr;
                if (pn == 0) {
                    float ss = 0.f;
#pragma unroll
                    for (int bj = 0; bj < 2; ++bj) { const f32x4 v0 = acc[ai][bj][m][0], v1 = acc[ai][bj][m][1]; const int lc = bj * HALF + wc * 32 + fq * 8;
                        ss += (v0[0] * v0[0] + v0[1] * v0[1]) + (v0[2] * v0[2] + v0[3] * v0[3]) + (v1[0] * v1[0] + v1[1] * v1[1]) + (v1[2] * v1[2] + v1[3] * v1[3]);
                        *(u32x4*)(HA + (size_t)row * 512 + lc) = pack8(v0, v1); }
                    ss += shx(ss, 16, fq * 16 + fr); ss += shx(ss, 32, fq * 16 + fr);
                    if (fq == 0) SSQ[(size_t)row * 8 + wc] = ss;
                } else if (pn == 1) {
                    { const f32x4 v0 = acc[ai][0][m][0], v1 = acc[ai][0][m][1]; const int lc = wc * 32 + fq * 8;
                      float ss = (v0[0] * v0[0] + v0[1] * v0[1]) + (v0[2] * v0[2] + v0[3] * v0[3]) + (v1[0] * v1[0] + v1[1] * v1[1]) + (v1[2] * v1[2] + v1[3] * v1[3]);
                      *(u32x4*)(HA + (size_t)row * 512 + 256 + lc) = pack8(v0, v1);
                      ss += shx(ss, 16, fq * 16 + fr); ss += shx(ss, 32, fq * 16 + fr);
                      if (fq == 0) SSQ[(size_t)row * 8 + 4 + wc] = ss; }
                    { f32x4 v0 = acc[ai][1][m][0], v1 = acc[ai][1][m][1]; const int lc = HALF + wc * 32 + fq * 8;
                      *(u32x4*)(HA + (size_t)row * 512 + 256 + lc) = pack8(v0, v1);
                      if (wc == 0) {
                          const int pos = row & (SEQ - 1); const f32x4* cs = (const f32x4*)(tabM + ((size_t)pos * 16 + 4 * fq) * 2);
                          rope8(v0, v1, cs[0], cs[1]);
                          const u32x4 w = pack8(v0, v1);
#pragma unroll
                          for (int h = 0; h < 8; ++h) *(u32x4*)(KM + (size_t)row * 768 + h * 96 + 64 + fq * 8) = w;
                      } else if (wc == 1 && fq == 0) {
                          const int b = row >> 12, t = row & (SEQ - 1);
#pragma unroll
                          for (int h = 0; h < 4; ++h) { LOGF[((size_t)b * 8 + h) * SEQ + t] = logsigmoid_f(v0[h] + b_f[h]); LOGF[((size_t)b * 8 + 4 + h) * SEQ + t] = logsigmoid_f(v1[h] + b_f[4 + h]); }
                      } }
                } else {
#pragma unroll
                    for (int bj = 0; bj < 2; ++bj) { f32x4 v0 = acc[ai][bj][m][0], v1 = acc[ai][bj][m][1]; const int lc = bj * HALF + wc * 32 + fq * 8;
                        if (pn < 4) { v0 = v0 * SC_64; v1 = v1 * SC_64; *(u32x4*)(FQ + (size_t)row * 512 + (pn - 2) * 256 + lc) = pack8(v0, v1); }
                        else if (pn < 6) { *(u32x4*)(FK + (size_t)row * 512 + (pn - 4) * 256 + lc) = pack8(v0, v1); }
                        else if (pn < 8) { *(u32x4*)(FV + (size_t)row * 512 + (pn - 6) * 256 + lc) = pack8(v0, v1); }
                        else {
#pragma unroll
                            for (int e = 0; e < 4; ++e) { v0[e] = silu_f(v0[e]); v1[e] = silu_f(v1[e]); }
                            *(u32x4*)(G + (size_t)row * 1024 + (pn - 8) * 256 + lc) = pack8(v0, v1); } }
                }
                asm volatile("" ::: "memory");
            }
    }
};

struct EpiUp {
    static constexpr bool PERM = true, AFTER_DRAIN = false;
    bf16_t *QM, *KM, *VM; const float* SSQ; const float* tabM;
    __device__ __forceinline__ void operator()(AccT acc, const Unit& u, int wr, int wc, int fr, int fq) const {
        const int pn = u.pn;
#pragma unroll
        for (int ai = 0; ai < 2; ++ai)
#pragma unroll
            for (int m = 0; m < 4; ++m) {
                const int row = u.pm * BM + ai * HALF + wr * 64 + m * 16 + fr;
                const f32x4 s0 = *(const f32x4*)(SSQ + (size_t)row * 8 + (pn < 3 ? 0 : 4)); const f32x4 s1 = s0;
                if (pn < 3) {
                    const float rq = (1.0f / sqrtf(((s0[0] + s0[1]) + (s0[2] + s0[3])) * (1.0f / 256.0f) + RMS_EPS)) * SC_MLA;
#pragma unroll
                    for (int bj = 0; bj < 2; ++bj) { f32x4 v0 = acc[ai][bj][m][0] * rq, v1 = acc[ai][bj][m][1] * rq; const int gc = pn * 256 + bj * HALF + wc * 32 + fq * 8;
                        const int p = gc % 96;
                        if (p >= 64) { const int pos = row & (SEQ - 1); const f32x4* cs = (const f32x4*)(tabM + ((size_t)pos * 16 + ((p - 64) >> 1)) * 2); rope8(v0, v1, cs[0], cs[1]); }
                        *(u32x4*)(QM + (size_t)row * 768 + gc) = pack8(v0, v1); }
                } else {
                    const float rk = 1.0f / sqrtf(((s1[0] + s1[1]) + (s1[2] + s1[3])) * (1.0f / 128.0f) + RMS_EPS);
#pragma unroll
                    for (int bj = 0; bj < 2; ++bj) { const f32x4 v0 = acc[ai][bj][m][0] * rk, v1 = acc[ai][bj][m][1] * rk; const int gc = (pn - 3) * 256 + bj * HALF + wc * 32 + fq * 8;
                        const int head = gc >> 7, e = gc & 127;
                        if (e < 64) *(u32x4*)(KM + (size_t)row * 768 + head * 96 + e) = pack8(v0, v1);
                        else *(u32x4*)(VM + (size_t)row * 512 + head * 64 + (e - 64)) = pack8(v0, v1); }
                }
                asm volatile("" ::: "memory");
            }
    }
};

struct EpiOddIn {
    static constexpr bool PERM = true, AFTER_DRAIN = false;
    bf16_t *QS, *KS, *VS, *G; const float* tabS;
    __device__ __forceinline__ void operator()(AccT acc, const Unit& u, int wr, int wc, int fr, int fq) const {
        const int pn = u.pn;
#pragma unroll
        for (int ai = 0; ai < 2; ++ai)
#pragma unroll
            for (int m = 0; m < 4; ++m) {
                const int row = u.pm * BM + ai * HALF + wr * 64 + m * 16 + fr; const int pos = row & (SEQ - 1);
#pragma unroll
                for (int bj = 0; bj < 2; ++bj) { f32x4 v0 = acc[ai][bj][m][0], v1 = acc[ai][bj][m][1]; const int lc = bj * HALF + wc * 32 + fq * 8;
                    if (pn < 4) { const f32x4* cs = (const f32x4*)(tabS + ((size_t)pos * 32 + ((lc & 63) >> 1)) * 2); rope8(v0, v1, cs[0], cs[1]);
                        v0 = v0 * SC_64; v1 = v1 * SC_64; *(u32x4*)(QS + (size_t)row * 1024 + pn * 256 + lc) = pack8(v0, v1); }
                    else if (pn == 4) {
                        if (bj == 0) { const f32x4* cs = (const f32x4*)(tabS + ((size_t)pos * 32 + ((lc & 63) >> 1)) * 2); rope8(v0, v1, cs[0], cs[1]); *(u32x4*)(KS + (size_t)row * 128 + lc) = pack8(v0, v1); }
                        else *(u32x4*)(VS + (size_t)row * 128 + (lc - HALF)) = pack8(v0, v1); }
                    else {
#pragma unroll
                        for (int e = 0; e < 4; ++e) { v0[e] = silu_f(v0[e]); v1[e] = silu_f(v1[e]); }
                        *(u32x4*)(G + (size_t)row * 1024 + (pn - 5) * 256 + lc) = pack8(v0, v1); } }
                asm volatile("" ::: "memory");
            }
    }
};

struct EpiResid {
    static constexpr bool PERM = false, AFTER_DRAIN = false;
    const float* base; float* out;
    __device__ __forceinline__ void operator()(AccT acc, const Unit& u, int wr, int wc, int fr, int fq) const {
#pragma unroll
        for (int ai = 0; ai < 2; ++ai)
#pragma unroll
            for (int m = 0; m < 4; ++m) { const size_t off = (size_t)(u.pm * BM + ai * HALF + wr * 64 + m * 16 + fr) * DMODEL + u.pn * BM + wc * 32 + 4 * fq;
#pragma unroll
                for (int bj = 0; bj < 2; ++bj)
#pragma unroll
                    for (int n = 0; n < 2; ++n) { const f32x4 bs = *(const f32x4*)(base + off + bj * HALF + n * 16); *(f32x4*)(out + off + bj * HALF + n * 16) = bs * ALPHA + acc[ai][bj][m][n]; } }
    }
};
}

namespace att {
constexpr int KBUF = 12288, VBUF = 8192, BBUF = 256, BUFSZ = KBUF + VBUF + BBUF;
constexpr int OFF_WS = 2 * BUFSZ, OFF_OST = OFF_WS + NWAVES * 256, LDS_TOTAL = OFF_OST + NWAVES * 4096;
static_assert(LDS_TOTAL <= RING_BYTES, "attention LDS");
__device__ __forceinline__ int crow(int r, int hi) { return (r & 3) + 8 * (r >> 2) + 4 * hi; }
__device__ __forceinline__ s16x4 vtr(const LAS unsigned char* p) { typedef short v4i16_t __attribute__((ext_vector_type(4))); return __builtin_bit_cast(s16x4, __builtin_amdgcn_ds_read_tr16_b64_v4i16((LAS v4i16_t*)p)); }

template <int DK, int MODE>
__device__ __forceinline__ void attn_unit(LAS unsigned char* lds, const bf16_t* Qb, int ldq, const bf16_t* Kb, int ldk, const bf16_t* Vb, int ldv, bf16_t* Gb, int ldg,
                                          const float* cum, float sink2, int q0) {
    int tid_ = threadIdx.x; asm volatile("" : "+v"(tid_));
    const int tid = tid_, lane = tid & 63, wid = __builtin_amdgcn_readfirstlane(tid >> 6), r32 = lane & 31, hi = lane >> 5;
    const int qw = q0 + 32 * wid;
    bf16x8 qr[DK / 16];
#pragma unroll
    for (int d0 = 0; d0 < DK / 16; ++d0) qr[d0] = *(const bf16x8*)(Qb + (size_t)(qw + r32) * ldq + d0 * 16 + hi * 8);
    float ct2 = 0.f; if (MODE == 1) ct2 = cum[qw + r32];
    const int kbeg = (MODE == 2) ? (q0 >= 128 ? q0 - 128 : 0) : 0, kend = q0 + 256, nt = (kend - kbeg) >> 6;
    LAS float* wsf = (LAS float*)(lds + OFF_WS) + wid * 64;
    u32x4 kst0, kst1 = (u32x4){0u, 0u, 0u, 0u}, vst; float bst = 0.f;
#define ATT_ISSUE(k0_) do { const int k0i = (k0_); \
        kst0 = *(const u32x4*)(Kb + (size_t)(k0i + lane) * ldk + wid * 8); \
        if (DK == 96 && wid < 4) kst1 = *(const u32x4*)(Kb + (size_t)(k0i + lane) * ldk + (8 + wid) * 8); \
        vst = *(const u32x4*)(Vb + (size_t)(k0i + (tid >> 3)) * ldv + ((tid >> 2) & 1) * 32 + (tid & 3) * 8); \
        if (MODE == 1 && tid < 64) bst = cum[k0i + tid]; } while (0)
#define ATT_COMMIT(bo_) do { const int boi = (bo_); \
        *(LAS u32x4*)(lds + boi + wid * 1024 + lane * 16) = kst0; \
        if (DK == 96 && wid < 4) *(LAS u32x4*)(lds + boi + (8 + wid) * 1024 + lane * 16) = kst1; \
        *(LAS u32x4*)(lds + boi + KBUF + ((tid >> 2) & 1) * 4096 + (tid >> 3) * 64 + (tid & 3) * 16) = vst; \
        if (MODE == 1 && tid < 64) *(LAS float*)(lds + boi + KBUF + VBUF + tid * 4) = bst; } while (0)
    float mhat = -64.f, lsum = 0.f; f32x16 o0 = f32x16{}, o1 = f32x16{};
    ATT_ISSUE(kbeg); ATT_COMMIT(0); __syncthreads();
    const int vaddr = ((lane >> 4) & 1) * 32 + (lane & 3) * 8 + (4 * hi + ((lane & 15) >> 2)) * 64;
    for (int t = 0; t < nt; ++t) {
        const int cur = (t & 1) * BUFSZ, k0 = kbeg + 64 * t;
        if (t + 1 < nt) ATT_ISSUE(k0 + 64);
        const bool need = (MODE == 2) ? (k0 + 63 >= qw - 127 && k0 <= qw + 31) : (k0 <= qw + 31);
        if (need) {
            f32x16 p0, p1; const float ci = ct2 - mhat;
#pragma unroll
            for (int r = 0; r < 16; ++r) { p0[r] = ci; p1[r] = ci; }
#pragma unroll
            for (int d0 = 0; d0 < DK / 16; ++d0) {
                const bf16x8 b0 = *(const LAS bf16x8*)(lds + cur + (2 * d0 + hi) * 1024 + r32 * 16);
                const bf16x8 b1 = *(const LAS bf16x8*)(lds + cur + (2 * d0 + hi) * 1024 + 512 + r32 * 16);
                p0 = __builtin_amdgcn_mfma_f32_32x32x16_bf16(b0, qr[d0], p0, 0, 0, 0);
                p1 = __builtin_amdgcn_mfma_f32_32x32x16_bf16(b1, qr[d0], p1, 0, 0, 0);
            }
            if (MODE == 1) {
#pragma unroll
                for (int g = 0; g < 4; ++g) { const f32x4 c0 = *(const LAS f32x4*)(lds + cur + KBUF + VBUF + (8 * g + 4 * hi) * 4), c1 = *(const LAS f32x4*)(lds + cur + KBUF + VBUF + (32 + 8 * g + 4 * hi) * 4);
#pragma unroll
                    for (int e = 0; e < 4; ++e) { p0[4 * g + e] -= c0[e]; p1[4 * g + e] -= c1[e]; } }
            }
            if (MODE == 2 || k0 + 63 > qw) {
                const int q = qw + r32;
#pragma unroll
                for (int r = 0; r < 16; ++r) { const int kv = k0 + crow(r, hi);
                    const bool bad0 = (kv > q) || (MODE == 2 && q - kv >= 128), bad1 = (kv + 32 > q) || (MODE == 2 && q - (kv + 32) >= 128);
                    p0[r] = bad0 ? -INFINITY : p0[r]; p1[r] = bad1 ? -INFINITY : p1[r]; }
            }
            float rm = fmaxf(p0[0], p1[0]);
#pragma unroll
            for (int r = 1; r < 16; ++r) rm = fmaxf(rm, fmaxf(p0[r], p1[r]));
            rm = swap32_max(rm);
            if (__any(rm > 8.0f)) {
                const float dl = fmaxf(rm, 0.f); mhat += dl;
#pragma unroll
                for (int r = 0; r < 16; ++r) { p0[r] -= dl; p1[r] -= dl; }
                const float f = __builtin_amdgcn_exp2f(-dl); lsum *= f;
                if (hi == 0) wsf[r32] = f;
                LDS_WAIT();
#pragma unroll
                for (int g = 0; g < 4; ++g) { const f32x4 fv = *(const LAS f32x4*)(wsf + 8 * g + 4 * hi);
#pragma unroll
                    for (int e = 0; e < 4; ++e) { o0[4 * g + e] *= fv[e]; o1[4 * g + e] *= fv[e]; } }
            }
            float sacc = 0.f;
#pragma unroll
            for (int r = 0; r < 16; ++r) { p0[r] = __builtin_amdgcn_exp2f(p0[r]); p1[r] = __builtin_amdgcn_exp2f(p1[r]); sacc += p0[r] + p1[r]; }
            lsum += sacc;
            u32x4 pw[4];
#pragma unroll
            for (int e = 0; e < 4; ++e) { pw[0][e] = cvt_pk_bf16(p0[2 * e], p0[2 * e + 1]); pw[1][e] = cvt_pk_bf16(p0[8 + 2 * e], p0[8 + 2 * e + 1]);
                                          pw[2][e] = cvt_pk_bf16(p1[2 * e], p1[2 * e + 1]); pw[3][e] = cvt_pk_bf16(p1[8 + 2 * e], p1[8 + 2 * e + 1]); }
            const LAS unsigned char* vb = lds + cur + KBUF + vaddr;
#pragma unroll
            for (int s = 0; s < 4; ++s) {
                const s16x4 l0 = vtr(vb + s * 1024), h0 = vtr(vb + s * 1024 + 512), l1 = vtr(vb + 4096 + s * 1024), h1 = vtr(vb + 4096 + s * 1024 + 512);
                const bf16x8 vf0 = (bf16x8){l0[0], l0[1], l0[2], l0[3], h0[0], h0[1], h0[2], h0[3]}, vf1 = (bf16x8){l1[0], l1[1], l1[2], l1[3], h1[0], h1[1], h1[2], h1[3]};
                const bf16x8 pa = __builtin_bit_cast(bf16x8, pw[s]);
                o0 = __builtin_amdgcn_mfma_f32_32x32x16_bf16(pa, vf0, o0, 0, 0, 0);
                o1 = __builtin_amdgcn_mfma_f32_32x32x16_bf16(pa, vf1, o1, 0, 0, 0);
            }
        }
        if (t + 1 < nt) ATT_COMMIT(cur == 0 ? BUFSZ : 0);
        __syncthreads();
    }
    lsum = swap32_add(lsum);
    if (MODE == 2) lsum += __builtin_amdgcn_exp2f(sink2 - mhat);
    if (hi == 0) wsf[32 + r32] = lsum;
    LDS_WAIT();
    LAS bf16_t* stg = (LAS bf16_t*)(lds + OFF_OST) + wid * 2048;
#pragma unroll
    for (int g = 0; g < 4; ++g) { const f32x4 lv = *(const LAS f32x4*)(wsf + 32 + 8 * g + 4 * hi);
#pragma unroll
        for (int e = 0; e < 4; ++e) { const float rl = 1.0f / lv[e]; const int orow = 8 * g + 4 * hi + e;
            stg[orow * 64 + r32] = (bf16_t)(cvt_pk_bf16(o0[4 * g + e] * rl, 0.f) & 0xffffu); stg[orow * 64 + 32 + r32] = (bf16_t)(cvt_pk_bf16(o1[4 * g + e] * rl, 0.f) & 0xffffu); } }
    LDS_WAIT();
#pragma unroll
    for (int i = 0; i < 4; ++i) { const int row = i * 8 + (lane >> 3), ch = lane & 7;
        const u32x4 ov = *(const LAS u32x4*)(stg + row * 64 + ch * 8);
        bf16_t* gp = Gb + (size_t)(qw + row) * ldg + ch * 8; const u32x4 gv = *(const u32x4*)gp; u32x4 w;
#pragma unroll
        for (int e = 0; e < 4; ++e) w[e] = cvt_pk_bf16(bf_lo(ov[e]) * bf_lo(gv[e]), bf_hi(ov[e]) * bf_hi(gv[e]));
        *(u32x4*)gp = w; }
    LDS_WAIT();
    __syncthreads();
#undef ATT_ISSUE
#undef ATT_COMMIT
}
}

struct Args { const float* in[15]; float* out; unsigned char* ws; int ph_lo, ph_hi; };

struct Frame {
    LAS unsigned char* lds; int tid, lane, wave, vcu, G; unsigned char* ws;
};

__device__ __forceinline__ float wave_sum(float v, int lane) {
#pragma unroll
    for (int o = 1; o < 64; o <<= 1) v += shx(v, o, lane);
    return v;
}

__device__ __forceinline__ int srccol(int kind, int n) {
    if (kind == 1) {
        if (n < 384) return n;
        if (n < 416) { const int p = n - 384; return 384 + (p >> 1) + 16 * (p & 1); }
        if (n < 424) return 1952 + (n - 416);
        if (n < 512) return -1;
        if (n < 2048) return 416 + (n - 512);
        return 1960 + (n - 2048);
    }
    if (kind == 2) { const int h = n / 96, p = n % 96; if (p < 64) return n; const int pp = p - 64; return h * 96 + 64 + (pp >> 1) + 16 * (pp & 1); }
    if (kind == 3) { if (n < 1152) { const int h = n >> 6, p = n & 63; return (h << 6) + (p >> 1) + 32 * (p & 1); } return n; }
    return n;
}
__device__ __forceinline__ void transpose_item(const float* W, int ldw, int Ksrc, const float* gain, bf16_t* WT, int Kdst, int kind, int k0, int n0, LAS float* scr, int lane) {
    const int nl = lane & 31, src = srccol(kind, n0 + nl);
#pragma unroll 8
    for (int i = 0; i < 32; ++i) { const int kk = 2 * i + (lane >> 5), k = k0 + kk; float v = 0.f;
        if (src >= 0 && k < Ksrc) { v = W[(size_t)k * ldw + src]; if (gain) v *= gain[k]; }
        scr[kk * 33 + nl] = v; }
    LDS_WAIT(); asm volatile("" ::: "memory");
    const int c = lane & 7;
#pragma unroll
    for (int j = 0; j < 4; ++j) { const int n = (lane >> 3) + 8 * j; const LAS float* s = scr + (8 * c) * 33 + n;
        u32x4 o; o.x = cvt_pk_bf16(s[0 * 33], s[1 * 33]); o.y = cvt_pk_bf16(s[2 * 33], s[3 * 33]); o.z = cvt_pk_bf16(s[4 * 33], s[5 * 33]); o.w = cvt_pk_bf16(s[6 * 33], s[7 * 33]);
        *(u32x4*)(WT + (size_t)(n0 + n) * Kdst + k0 + 8 * c) = o; }
    LDS_WAIT(); asm volatile("" ::: "memory");
}

__device__ __forceinline__ void p0_prologue(Frame& F, const Args& a) {
    LAS float* scr = (LAS float*)(F.lds + F.wave * 16384);
    const int gw = F.vcu * NWAVES + F.wave, NGW = F.G * NWAVES;
    constexpr int IA = 16 * 96, IB = 4 * 24, IC = 4 * 32, ID = 16 * 32, IE = 16 * 72, IF_ = 16 * 32, IL = IA + IB + IC + ID + IE + IF_;
    for (int it = gw; it < 2 * IL; it += NGW) {
        const int j = it / IL; int r = it % IL; unsigned char* wl = F.ws + WS_W + (size_t)j * W_LAYER;
        if (r < IA) { transpose_item(a.in[1] + (size_t)j * DMODEL * EVEN_IN, EVEN_IN, DMODEL, nullptr, (bf16_t*)(wl + W_INE), DMODEL, 1, 64 * (r / 96), 32 * (r % 96), scr, F.lane); continue; } r -= IA;
        if (r < IB) { transpose_item(a.in[3] + (size_t)j * 256 * 768, 768, 256, a.in[2] + j * 256, (bf16_t*)(wl + W_UP), 256, 2, 64 * (r / 24), 32 * (r % 24), scr, F.lane); continue; } r -= IB;
        if (r < IC) { transpose_item(a.in[5] + (size_t)j * 128 * 1024, 1024, 128, a.in[4] + j * 128, (bf16_t*)(wl + W_UP) + 768 * 256, 256, 0, 64 * (r / 32), 32 * (r % 32), scr, F.lane); continue; } r -= IC;
        if (r < ID) { transpose_item(a.in[7] + (size_t)j * DMODEL * DMODEL, DMODEL, DMODEL, nullptr, (bf16_t*)(wl + W_OUTE), DMODEL, 0, 64 * (r / 32), 32 * (r % 32), scr, F.lane); continue; } r -= ID;
        if (r < IE) { transpose_item(a.in[10] + (size_t)j * DMODEL * ODD_IN, ODD_IN, DMODEL, nullptr, (bf16_t*)(wl + W_INO), DMODEL, 3, 64 * (r / 72), 32 * (r % 72), scr, F.lane); continue; } r -= IE;
        transpose_item(a.in[12] + (size_t)j * DMODEL * DMODEL, DMODEL, DMODEL, nullptr, (bf16_t*)(wl + W_OUTO), DMODEL, 0, 64 * (r / 32), 32 * (r % 32), scr, F.lane);
    }
    bf16_t* XB = (bf16_t*)(F.ws + WS_XB);
    for (int m = gw; m < MTOK; m += NGW) { const f32x4* xr = (const f32x4*)(a.in[0] + (size_t)m * DMODEL) + F.lane; u32x2* o8 = (u32x2*)(XB + (size_t)m * DMODEL) + F.lane;
#pragma unroll
        for (int j = 0; j < 4; ++j) { const f32x4 v = xr[64 * j]; u32x2 w; w.x = cvt_pk_bf16(v[0], v[1]); w.y = cvt_pk_bf16(v[2], v[3]); o8[64 * j] = w; } }
    float* tabS = (float*)(F.ws + WS_TABS); float* tabM = (float*)(F.ws + WS_TABM);
    const int gt = (F.vcu * NWAVES + F.wave) * 64 + F.lane, NT = F.G * NWAVES * 64;
    for (int idx = gt; idx < SEQ * 32 + SEQ * 16; idx += NT) {
        if (idx < SEQ * 32) { const int pos = idx >> 5, i = idx & 31; const float inv = powf(10000.0f, -(float)(2 * i) / 64.0f); const float ang = (float)pos * inv; tabS[2 * idx] = cosf(ang); tabS[2 * idx + 1] = sinf(ang); }
        else { const int jx = idx - SEQ * 32; const int pos = jx >> 4, i = jx & 15; const float inv = powf(10000.0f, -(float)(2 * i) / 32.0f); const float ang = (float)pos * inv; tabM[2 * jx] = cosf(ang); tabM[2 * jx + 1] = sinf(ang); }
    }
}

__device__ __forceinline__ void scan_seq(const float* src, float* dst, int lane) {
    asm volatile("" : "+v"(lane));
    float carry = 0.f;
    for (int j = 0; j < SEQ / 256; ++j) {
        f32x4 v = *(const f32x4*)(src + j * 256 + lane * 4);
        v[1] += v[0]; v[2] += v[1]; v[3] += v[2];
        const float tot = v[3]; float inc = tot;
#pragma unroll
        for (int o = 1; o < 64; o <<= 1) { const float t = __int_as_float(__builtin_amdgcn_ds_bpermute((lane - o) << 2, __float_as_int(inc))); if (lane >= o) inc += t; }
        const float ex = inc - tot + carry;
        f32x4 w; w[0] = (v[0] + ex) * LOG2E; w[1] = (v[1] + ex) * LOG2E; w[2] = (v[2] + ex) * LOG2E; w[3] = (v[3] + ex) * LOG2E;
        *(f32x4*)(dst + j * 256 + lane * 4) = w;
        carry += __int_as_float(__builtin_amdgcn_readlane(__float_as_int(inc), 63));
    }
}

__device__ __forceinline__ void ln_rows(Frame& F, float* z, const float* g, const float* b, bf16_t* XB) {
    const int gw = F.vcu * NWAVES + F.wave, NGW = F.G * NWAVES;
    int lane_ = F.lane; asm volatile("" : "+v"(lane_));
    f32x4 gv[4], bv[4];
#pragma unroll
    for (int j = 0; j < 4; ++j) { gv[j] = ((const f32x4*)g)[lane_ + 64 * j]; bv[j] = ((const f32x4*)b)[lane_ + 64 * j]; }
    for (int m = gw; m < MTOK; m += NGW) {
        f32x4* xr = (f32x4*)(z + (size_t)m * DMODEL) + lane_; f32x4 v[4]; float s = 0.f;
#pragma unroll
        for (int j = 0; j < 4; ++j) { v[j] = xr[64 * j]; s += (v[j][0] + v[j][1]) + (v[j][2] + v[j][3]); }
        const float mean = wave_sum(s, lane_) * (1.f / DMODEL); float s2 = 0.f;
#pragma unroll
        for (int j = 0; j < 4; ++j) { v[j] = v[j] - mean; s2 += (v[j][0] * v[j][0] + v[j][1] * v[j][1]) + (v[j][2] * v[j][2] + v[j][3] * v[j][3]); }
        const float rstd = 1.f / sqrtf(wave_sum(s2, lane_) * (1.f / DMODEL) + LN_EPS);
        u32x2* o8 = (u32x2*)(XB + (size_t)m * DMODEL) + lane_;
#pragma unroll
        for (int j = 0; j < 4; ++j) { const f32x4 y = v[j] * rstd * gv[j] + bv[j]; xr[64 * j] = y; u32x2 w; w.x = cvt_pk_bf16(y[0], y[1]); w.y = cvt_pk_bf16(y[2], y[3]); o8[64 * j] = w; }
    }
}

constexpr int N_PHASES = 19;
__global__ void __launch_bounds__(NWAVES * 64, 2) fwd(Args args) {
    extern __shared__ __attribute__((aligned(16))) unsigned char lds_raw[];
    Frame F;
    F.lds = (LAS unsigned char*)lds_raw; F.tid = threadIdx.x; F.lane = F.tid & 63; F.wave = __builtin_amdgcn_readfirstlane(F.tid >> 6);
    F.G = gridDim.x; { const int bx = blockIdx.x; F.vcu = (F.G % 8 == 0) ? (bx % 8) * (F.G / 8) + bx / 8 : bx; }
    F.ws = args.ws;
    unsigned char* ws = args.ws;
    const int lo = args.ph_lo, hi = args.ph_hi;
#ifndef PHM
#define PHM 0xFFFF
#endif
#define RUN(k) (lo <= (k) && (k) < hi)
#define SEAM(k) do { if (RUN(k) && RUN((k) + 1)) {   } } while (0)
    bf16_t* XB = (bf16_t*)(ws + WS_XB); bf16_t* G = (bf16_t*)(ws + WS_G);
    float* tabS = (float*)(ws + WS_TABS); float* tabM = (float*)(ws + WS_TABM);

    if ((PHM & 1) && RUN(0)) { p0_prologue(F, args); }
    SEAM(0);
    for (int L = 0; L < DEPTH; ++L) {
        const int j = L >> 1, pb = 1 + 9 * (L >> 1) + 5 * (L & 1);
        unsigned char* wl = ws + WS_W + (size_t)j * W_LAYER;
        const float* xbase = (L == 0) ? args.in[0] : args.out;
        if ((L & 1) == 0) {
            if ((PHM & 2) && RUN(pb)) {
                pg8::Gemm g{XB, (const bf16_t*)(wl + W_INE), MTOK, EVEN_INP, DMODEL, DMODEL, 1 << 30, 0}; pg8::StaticOrder S; S.init(MTOK, EVEN_INP, F.G, (int)blockIdx.x);
                pg8::EpiEvenIn E{(bf16_t*)(ws + WS_HA), (bf16_t*)(ws + WS_KM), (bf16_t*)(ws + WS_FQ), (bf16_t*)(ws + WS_FK), (bf16_t*)(ws + WS_FV), G, (float*)(ws + WS_SSQ), (float*)(ws + WS_LOGF), args.in[6] + j * 8, tabM};
                pg8::gemm_phase<pg8::EpiEvenIn, true>(F.lds, g, S, E);
            }
            SEAM(pb);
            if ((PHM & 4) && RUN(pb + 1)) {
                if (F.wave == 0) for (int sq = F.G - 1 - (int)blockIdx.x; sq < NBATCH * 8; sq += F.G) scan_seq((const float*)(ws + WS_LOGF) + (size_t)sq * SEQ, (float*)(ws + WS_CUM) + (size_t)sq * SEQ, F.lane);
                pg8::Gemm g{(const bf16_t*)(ws + WS_HA), (const bf16_t*)(wl + W_UP), MTOK, 1792, 256, 512, 3, 256}; pg8::StaticOrder S; S.init(MTOK, 1792, F.G, (int)blockIdx.x);
                pg8::EpiUp E{(bf16_t*)(ws + WS_QM), (bf16_t*)(ws + WS_KM), (bf16_t*)(ws + WS_VM), (const float*)(ws + WS_SSQ), tabM};
                pg8::gemm_phase<pg8::EpiUp, true>(F.lds, g, S, E);
            }
            SEAM(pb + 1);
            if ((PHM & 8) && RUN(pb + 2)) {
                for (int jj = F.vcu; jj < 1024; jj += F.G) {
                    const int i = jj >> 8, c = jj & 255, bh = c >> 3, s = c & 7, b = bh >> 3, h = bh & 7, qb = (i & 1) ? 15 - s : s;
                    const size_t r0 = (size_t)b * SEQ;
                    if (i < 2) att::attn_unit<96, 0>(F.lds, (const bf16_t*)(ws + WS_QM) + r0 * 768 + h * 96, 768, (const bf16_t*)(ws + WS_KM) + r0 * 768 + h * 96, 768,
                                                     (const bf16_t*)(ws + WS_VM) + r0 * 512 + h * 64, 512, G + r0 * 1024 + h * 64, 1024, nullptr, 0.f, qb * 256);
                    else att::attn_unit<64, 1>(F.lds, (const bf16_t*)(ws + WS_FQ) + r0 * 512 + h * 64, 512, (const bf16_t*)(ws + WS_FK) + r0 * 512 + h * 64, 512,
                                               (const bf16_t*)(ws + WS_FV) + r0 * 512 + h * 64, 512, G + r0 * 1024 + 512 + h * 64, 1024, (const float*)(ws + WS_CUM) + (size_t)bh * SEQ, 0.f, qb * 256);
                }
            }
            SEAM(pb + 2);
            if ((PHM & 16) && RUN(pb + 3)) {
                pg8::Gemm g{G, (const bf16_t*)(wl + W_OUTE), MTOK, DMODEL, DMODEL, DMODEL, 1 << 30, 0}; pg8::StaticOrder S; S.init(MTOK, DMODEL, F.G, (int)blockIdx.x);
                pg8::EpiResid E{xbase, args.out};
                pg8::gemm_phase<pg8::EpiResid, true>(F.lds, g, S, E);
            }
            SEAM(pb + 3);
            if ((PHM & 32) && RUN(pb + 4)) ln_rows(F, args.out, args.in[8] + j * DMODEL, args.in[9] + j * DMODEL, XB);
            SEAM(pb + 4);
        } else {
            if ((PHM & 64) && RUN(pb)) {
                pg8::Gemm g{XB, (const bf16_t*)(wl + W_INO), MTOK, ODD_IN, DMODEL, DMODEL, 1 << 30, 0}; pg8::StaticOrder S; S.init(MTOK, ODD_IN, F.G, (int)blockIdx.x);
                pg8::EpiOddIn E{(bf16_t*)(ws + WS_QS), (bf16_t*)(ws + WS_KS), (bf16_t*)(ws + WS_VS), G, tabS};
                pg8::gemm_phase<pg8::EpiOddIn, true>(F.lds, g, S, E);
            }
            SEAM(pb);
            if ((PHM & 128) && RUN(pb + 1)) {
                for (int jj = F.vcu; jj < 1024; jj += F.G) {
                    const int hq = jj & 7, qb = (jj >> 3) & 15, hk = (jj >> 7) & 1, b = jj >> 8, h = hk * 8 + hq;
                    const size_t r0 = (size_t)b * SEQ;
                    att::attn_unit<64, 2>(F.lds, (const bf16_t*)(ws + WS_QS) + r0 * 1024 + h * 64, 1024, (const bf16_t*)(ws + WS_KS) + r0 * 128 + hk * 64, 128,
                                          (const bf16_t*)(ws + WS_VS) + r0 * 128 + hk * 64, 128, G + r0 * 1024 + h * 64, 1024, nullptr, args.in[11][j * 16 + h] * LOG2E, qb * 256);
                }
            }
            SEAM(pb + 1);
            if ((PHM & 256) && RUN(pb + 2)) {
                pg8::Gemm g{G, (const bf16_t*)(wl + W_OUTO), MTOK, DMODEL, DMODEL, DMODEL, 1 << 30, 0}; pg8::StaticOrder S; S.init(MTOK, DMODEL, F.G, (int)blockIdx.x);
                pg8::EpiResid E{xbase, args.out};
                pg8::gemm_phase<pg8::EpiResid, true>(F.lds, g, S, E);
            }
            SEAM(pb + 2);
            if ((PHM & 512) && RUN(pb + 3)) ln_rows(F, args.out, args.in[13] + j * DMODEL, args.in[14] + j * DMODEL, XB);
            SEAM(pb + 3);
        }
    }
#undef RUN
#undef SEAM
}

extern "C" void kernel_launch(void* const* d_in, const int* in_sizes, int n_in, void* d_out, int out_size, void* d_ws, size_t ws_size, hipStream_t stream) {
    static int grid = 0;
    if (grid == 0) {
        if (n_in != 15 || in_sizes[0] != MTOK * DMODEL || out_size != MTOK * DMODEL || ws_size < WS_END) { fprintf(stderr, "kernel_launch: unexpected shapes (n_in %d, in0 %d, out %d, ws %zu)\n", n_in, n_in > 0 ? in_sizes[0] : -1, out_size, ws_size); grid = -1; return; }
        int dev = 0, cus = 0;
        if (hipGetDevice(&dev) != hipSuccess || hipDeviceGetAttribute(&cus, hipDeviceAttributeMultiprocessorCount, dev) != hipSuccess) { grid = -1; return; }
        if (hipFuncSetAttribute((const void*)fwd, hipFuncAttributeMaxDynamicSharedMemorySize, LDS_BYTES) != hipSuccess) { fprintf(stderr, "kernel_launch: hipFuncSetAttribute failed\n"); grid = -1; return; }
        grid = cus;
    }
    if (grid < 0) return;
    Args a{};
    for (int i = 0; i < 15; ++i) a.in[i] = (const float*)d_in[i];
    a.out = (float*)d_out; a.ws = (unsigned char*)d_ws;
    if (MK_N_LAUNCHES == 1) { a.ph_lo = 0; a.ph_hi = N_PHASES; hipLaunchKernelGGL(fwd, dim3(grid), dim3(NWAVES * 64), LDS_BYTES, stream, a); }
    else for (int p = 0; p < N_PHASES; ++p) { a.ph_lo = p; a.ph_hi = p + 1; hipLaunchKernelGGL(fwd, dim3(grid), dim3(NWAVES * 64), LDS_BYTES, stream, a); }
}
```

```cpp
#include <hip/hip_runtime.h>
#include <cstdio>
#include <cstdint>

#ifndef MK_N_LAUNCHES
#define MK_N_LAUNCHES 1
#endif

#define LAS __attribute__((address_space(3)))
typedef unsigned short bf16_t;
typedef short bf16x8 __attribute__((ext_vector_type(8)));
typedef short s16x4 __attribute__((ext_vector_type(4)));
typedef float f32x4 __attribute__((ext_vector_type(4)));
typedef float f32x2 __attribute__((ext_vector_type(2)));
typedef float f32x16 __attribute__((ext_vector_type(16)));
typedef unsigned u32x4 __attribute__((ext_vector_type(4)));
typedef unsigned u32x2 __attribute__((ext_vector_type(2)));

constexpr int NWAVES = 8;
constexpr int MTOK = 16384, DMODEL = 1024, SEQ = 4096, NBATCH = 4, DEPTH = 4;
constexpr int EVEN_IN = 2984, EVEN_INP = 3072, ODD_IN = 2304;
constexpr float RMS_EPS = 1e-6f, LN_EPS = 1e-5f;
constexpr float ALPHA = 1.6817928305074290f;
constexpr float LOG2E = 1.4426950408889634f;
constexpr float SC_MLA = 0.10206207261596575f * LOG2E;
constexpr float SC_64 = 0.125f * LOG2E;

constexpr size_t MiB = 1u << 20;
constexpr size_t WS_CTL = 0, CTL_ZERO_BYTES = 1 * MiB;
constexpr size_t WS_TABS = 1 * MiB;
constexpr size_t WS_TABM = 2 * MiB;
constexpr size_t WS_LOGF = 2 * MiB + 512 * 1024;
constexpr size_t WS_CUM = 3 * MiB;
constexpr size_t WS_SSQ = 3 * MiB + 512 * 1024;
constexpr size_t WS_W = 4 * MiB;
constexpr size_t W_INE = 0, W_UP = 6 * MiB, W_OUTE = 7 * MiB, W_INO = 9 * MiB, W_OUTO = 14 * MiB, W_LAYER = 16 * MiB;
constexpr size_t WS_XB = 36 * MiB;
constexpr size_t WS_G = 68 * MiB;
constexpr size_t WS_HA = 100 * MiB;
constexpr size_t WS_QM = 116 * MiB;
constexpr size_t WS_KM = 140 * MiB;
constexpr size_t WS_VM = 164 * MiB;
constexpr size_t WS_FQ = 180 * MiB, WS_FK = 196 * MiB, WS_FV = 212 * MiB;
constexpr size_t WS_QS = 116 * MiB;
constexpr size_t WS_KS = 148 * MiB, WS_VS = 152 * MiB;
constexpr size_t WS_END = 228 * MiB;

constexpr int RING_BYTES = 131072;
constexpr int LDS_BYTES = 147456;

__device__ __forceinline__ unsigned cvt_pk_bf16(float lo, float hi) { unsigned r; asm volatile("v_cvt_pk_bf16_f32 %0, %1, %2" : "=v"(r) : "v"(lo), "v"(hi)); return r; }
__device__ __forceinline__ float bf_lo(unsigned w) { return __uint_as_float(w << 16); }
__device__ __forceinline__ float bf_hi(unsigned w) { return __uint_as_float(w & 0xffff0000u); }
__device__ __forceinline__ u32x4 pack8(f32x4 a, f32x4 b) { u32x4 w; w.x = cvt_pk_bf16(a[0], a[1]); w.y = cvt_pk_bf16(a[2], a[3]); w.z = cvt_pk_bf16(b[0], b[1]); w.w = cvt_pk_bf16(b[2], b[3]); return w; }
__device__ __forceinline__ float silu_f(float g) { return g * __builtin_amdgcn_rcpf(1.0f + __expf(-g)); }
__device__ __forceinline__ float logsigmoid_f(float v) { return fminf(v, 0.f) - log1pf(__expf(-fabsf(v))); }
__device__ __forceinline__ float shx(float v, int mask, int lane) { return __int_as_float(__builtin_amdgcn_ds_bpermute((lane ^ mask) << 2, __float_as_int(v))); }
__device__ __forceinline__ float swap32_max(float v) { auto rr = __builtin_amdgcn_permlane32_swap(__float_as_uint(v), __float_as_uint(v), false, false); return fmaxf(__uint_as_float(rr[0]), __uint_as_float(rr[1])); }
__device__ __forceinline__ float swap32_add(float v) { auto rr = __builtin_amdgcn_permlane32_swap(__float_as_uint(v), __float_as_uint(v), false, false); return __uint_as_float(rr[0]) + __uint_as_float(rr[1]); }
#define LDS_WAIT() asm volatile("s_waitcnt lgkmcnt(0)" ::: "memory")
#define VM_WAIT() asm volatile("s_waitcnt vmcnt(0)" ::: "memory")
__device__ __forceinline__ void rope8(f32x4& v0, f32x4& v1, const f32x4 c0, const f32x4 c1) {
    const float a0 = v0[0], b0 = v0[1], a1 = v0[2], b1 = v0[3], a2 = v1[0], b2 = v1[1], a3 = v1[2], b3 = v1[3];
    v0[0] = a0 * c0[0] - b0 * c0[1]; v0[1] = b0 * c0[0] + a0 * c0[1];
    v0[2] = a1 * c0[2] - b1 * c0[3]; v0[3] = b1 * c0[2] + a1 * c0[3];
    v1[0] = a2 * c1[0] - b2 * c1[1]; v1[1] = b2 * c1[0] + a2 * c1[1];
    v1[2] = a3 * c1[2] - b3 * c1[3]; v1[3] = b3 * c1[2] + a3 * c1[3];
}

namespace pg8 {
constexpr int BM = 256, BK = 64, HALF = 128, HTB = HALF * BK * 2, STAGE_BYTES = 8 * HTB, NXCD = 8, WGM = 8;
__host__ __device__ __forceinline__ int lds_byte(int r, int c) { const int st = (r >> 4) * 2 + (c >> 5), rr = r & 15, cc = c & 31, ob = rr * 64 + cc * 2; return st * 1024 + (ob ^ (((ob >> 9) & 1) << 5)); }
__host__ __device__ __forceinline__ void stage_rc(int b, int& R, int& C) { const int st = b / 1024, sb = b % 1024, swz = sb ^ (((sb >> 9) & 1) << 5); R = (st >> 1) * 16 + swz / 64; C = (st & 1) * 32 + (swz % 64) / 2; }
__host__ __device__ __forceinline__ int perm32(int rho) { const int n = rho >> 4, i = rho & 15; return 8 * (i >> 2) + 4 * n + (i & 3); }

struct Unit { int pm, pn; };
struct Gemm { const bf16_t* A; const bf16_t* Bt; int M, N, K, lda, split_pn, split_off; };

struct StaticOrder {
    int nM, nN, nwg, G, c;
    __host__ __device__ void init(int M, int N, int G_, int c_) { nM = M / BM; nN = N / BM; nwg = nM * nN; G = G_; c = c_; }
    __host__ __device__ bool next(int i, Unit& u) const {
        const long L = (long)i * G + c; if (L >= nwg) return false;
        int wgid = (int)L; { const int q = nwg / NXCD, r = nwg % NXCD, xcd = wgid % NXCD, off = wgid / NXCD; wgid = (xcd < r ? xcd * (q + 1) : r * (q + 1) + (xcd - r) * q) + off; }
        const int nig = WGM * nN, gid = wgid / nig, fm = gid * WGM, gsz = (nM - fm) < WGM ? (nM - fm) : WGM;
        u.pm = fm + ((wgid % nig) % gsz); u.pn = (wgid % nig) / gsz; return true;
    }
};

template <class Epi, bool ALIGN_EPI>
__device__ __forceinline__ void gemm_phase(LAS unsigned char* lds, const Gemm g, const StaticOrder& S, const Epi& E) {
    int tid_ = threadIdx.x; asm volatile("" : "+v"(tid_));
    const int tid = tid_, wid = __builtin_amdgcn_readfirstlane(tid >> 6), lane = tid & 63, wr = wid >> 2, wc = wid & 3, fr = lane & 15, fq = lane >> 4;
    const int K = g.K, nt = K / BK, lda = g.lda;
    unsigned voffA[2], voffB[2];
#pragma unroll
    for (int i = 0; i < 2; ++i) { int R, C; stage_rc(tid * 16 + i * 8192, R, C); const int Rb = Epi::PERM ? ((R & ~31) + perm32(R & 31)) : R;
        voffA[i] = (unsigned)(R * lda + C) * 2u; voffB[i] = (unsigned)(Rb * K + C) * 2u; }
    const size_t kstep = (size_t)(BK * 2);
    const size_t hstepA = (size_t)HALF * lda * 2, hstepB = (size_t)HALF * K * 2;
    const size_t tstepA = 2 * hstepA, tstepB = 2 * hstepB;
    const unsigned ldsw = (unsigned)wid * 1024u;
    const int aoff = lds_byte(wr * 64 + fr, fq * 8), boff = lds_byte(wc * 32 + fr, fq * 8);
#define PG8_SA(b, h) (((b) * 2 + (h)) * HTB)
#define PG8_SB(b, h) ((4 + (b) * 2 + (h)) * HTB)
#define PG8_STAGE(bufoff, gbase, voff) do { _Pragma("unroll") for (int _i = 0; _i < 2; ++_i) \
        __builtin_amdgcn_global_load_lds((const unsigned*)((const char*)(gbase) + (voff)[_i]), (LAS unsigned*)(lds + (bufoff) + ldsw + _i * 8192), 16, 0, 0); } while (0)
#define PG8_LDA(dst, b, h) do { _Pragma("unroll") for (int m = 0; m < 4; ++m) _Pragma("unroll") for (int k = 0; k < 2; ++k) dst[m][k] = *(const LAS bf16x8*)(lds + PG8_SA(b, h) + aoff + m * 2048 + k * 1024); } while (0)
#define PG8_LDB(dst, b, h) do { _Pragma("unroll") for (int n = 0; n < 2; ++n) _Pragma("unroll") for (int k = 0; k < 2; ++k) dst[n][k] = *(const LAS bf16x8*)(lds + PG8_SB(b, h) + boff + n * 2048 + k * 1024); } while (0)
#define PG8_MMA(ai, bj, At, Bt) do { __builtin_amdgcn_s_setprio(1); _Pragma("unroll") for (int m = 0; m < 4; ++m) _Pragma("unroll") for (int n = 0; n < 2; ++n) _Pragma("unroll") for (int k = 0; k < 2; ++k) \
        acc[ai][bj][m][n] = __builtin_amdgcn_mfma_f32_16x16x32_bf16(Bt[n][k], At[m][k], acc[ai][bj][m][n], 0, 0, 0); __builtin_amdgcn_s_setprio(0); } while (0)
#define PG8_WAIT_V(n) asm volatile("s_waitcnt vmcnt(" #n ")" ::: "memory")
#define PG8_WAIT_L(n) asm volatile("s_waitcnt lgkmcnt(" #n ")" ::: "memory")
#define PG8_BAR __builtin_amdgcn_s_barrier()
#define PG8_SCHED __builtin_amdgcn_sched_barrier(0)
#define PG8_APTR(u) ((const char*)g.A + (size_t)(u).pm * tstepA + ((u).pn >= g.split_pn ? (size_t)g.split_off * 2 : (size_t)0))
    Unit cur, nxt; int ui = 0;
    if (!S.next(0, cur)) return;
    f32x4 acc[2][2][4][2];
#pragma unroll
    for (int a = 0; a < 2; ++a)
#pragma unroll
        for (int b = 0; b < 2; ++b)
#pragma unroll
            for (int m = 0; m < 4; ++m)
#pragma unroll
                for (int n = 0; n < 2; ++n) acc[a][b][m][n] = (f32x4){0.f, 0.f, 0.f, 0.f};
    bf16x8 At[4][2], B0[2][2], B1[2][2];
    const char* cA = PG8_APTR(cur); const char* cB = (const char*)g.Bt + (size_t)cur.pn * tstepB;
    PG8_STAGE(PG8_SB(0, 0), cB, voffB); PG8_STAGE(PG8_SB(0, 1), cB + hstepB, voffB); PG8_STAGE(PG8_SA(0, 0), cA, voffA); PG8_STAGE(PG8_SA(0, 1), cA + hstepA, voffA);
    if (wr == 1) PG8_BAR;
    PG8_WAIT_V(2); PG8_BAR;
    PG8_STAGE(PG8_SB(1, 0), cB + kstep, voffB); PG8_STAGE(PG8_SA(1, 0), cA + kstep, voffA); PG8_STAGE(PG8_SB(1, 1), cB + hstepB + kstep, voffB);
    PG8_WAIT_V(6); PG8_BAR;
    for (;;) {
        const bool has_next = S.next(ui + 1, nxt);
        const char* nA = has_next ? PG8_APTR(nxt) : cA; const char* nB = has_next ? (const char*)g.Bt + (size_t)nxt.pn * tstepB : cB;
#pragma nounroll
        for (int t = 0; t < nt; t += 2) {
            const bool last = (t == nt - 2);
            const char* a1 = cA + (size_t)(t + 1) * kstep;
            const char* a2 = last ? nA : cA + (size_t)(t + 2) * kstep; const char* b2 = last ? nB : cB + (size_t)(t + 2) * kstep;
            const char* a3 = a2 + kstep; const char* b3 = b2 + kstep;
            PG8_LDB(B0, 0, 0); PG8_LDB(B1, 0, 1); PG8_SCHED; PG8_LDA(At, 0, 0); PG8_STAGE(PG8_SA(1, 1), a1 + hstepA, voffA);
            PG8_WAIT_V(8); PG8_WAIT_L(0); PG8_BAR; PG8_MMA(0, 0, At, B0); PG8_MMA(0, 1, At, B1); PG8_BAR; PG8_SCHED;
            PG8_LDA(At, 0, 1); PG8_STAGE(PG8_SB(0, 0), b2, voffB); PG8_STAGE(PG8_SB(0, 1), b2 + hstepB, voffB); PG8_STAGE(PG8_SA(0, 0), a2, voffA);
            PG8_WAIT_V(8); PG8_WAIT_L(0); PG8_BAR; PG8_MMA(1, 0, At, B0); PG8_MMA(1, 1, At, B1); PG8_BAR; PG8_SCHED;
            PG8_LDB(B0, 1, 0); PG8_LDB(B1, 1, 1); PG8_SCHED; PG8_LDA(At, 1, 0); PG8_STAGE(PG8_SA(0, 1), a2 + hstepA, voffA);
            PG8_WAIT_V(8); PG8_WAIT_L(0); PG8_BAR; PG8_MMA(0, 0, At, B0); PG8_MMA(0, 1, At, B1); PG8_BAR; PG8_SCHED;
            PG8_LDA(At, 1, 1); PG8_STAGE(PG8_SB(1, 0), b3, voffB); PG8_STAGE(PG8_SB(1, 1), b3 + hstepB, voffB); PG8_STAGE(PG8_SA(1, 0), a3, voffA);
            PG8_WAIT_V(8); PG8_WAIT_L(0); PG8_BAR; PG8_MMA(1, 0, At, B0); PG8_MMA(1, 1, At, B1); PG8_BAR; PG8_SCHED;
        }
        if constexpr (ALIGN_EPI) { if (wr == 0) PG8_BAR; }
        if constexpr (!Epi::AFTER_DRAIN) { E(acc, cur, wr, wc, fr, fq); }
        if (!has_next) break;
#pragma unroll
        for (int a = 0; a < 2; ++a)
#pragma unroll
            for (int b = 0; b < 2; ++b)
#pragma unroll
                for (int m = 0; m < 4; ++m)
#pragma unroll
                    for (int n = 0; n < 2; ++n) acc[a][b][m][n] = (f32x4){0.f, 0.f, 0.f, 0.f};
        cur = nxt; cA = nA; cB = nB; ++ui;
        if constexpr (ALIGN_EPI) { if (wr == 1) PG8_BAR; }
    }
    PG8_WAIT_V(0);
    if constexpr (!ALIGN_EPI) { if (wr == 0) PG8_BAR; }
    PG8_BAR;
    if constexpr (Epi::AFTER_DRAIN) { E.fused(acc, cur, wr, wc, fr, fq, lds, wid, lane); }
#undef PG8_SA
#undef PG8_SB
#undef PG8_STAGE
#undef PG8_LDA
#undef PG8_LDB
#undef PG8_MMA
#undef PG8_WAIT_V
#undef PG8_WAIT_L
#undef PG8_BAR
#undef PG8_SCHED
#undef PG8_APTR
}

typedef const f32x4 (&AccT)[2][2][4][2];

struct EpiEvenIn {
    static constexpr bool PERM = true, AFTER_DRAIN = false;
    bf16_t *HA, *KM, *FQ, *FK, *FV, *G; float *SSQ, *LOGF; const float* b_f; const float* tabM;
    __device__ __forceinline__ void operator()(AccT acc, const Unit& u, int wr, int wc, int fr, int fq) const {
        const int pn = u.pn;
#pragma unroll
        for (int ai = 0; ai < 2; ++ai)
#pragma unroll
            for (int m = 0; m < 4; ++m) {
                const int row = u.pm * BM + ai * HALF + wr * 64 + m * 16 + fr;
                if (pn == 0) {
                    float ss = 0.f;
#pragma unroll
                    for (int bj = 0; bj < 2; ++bj) { const f32x4 v0 = acc[ai][bj][m][0], v1 = acc[ai][bj][m][1]; const int lc = bj * HALF + wc * 32 + fq * 8;
                        ss += (v0[0] * v0[0] + v0[1] * v0[1]) + (v0[2] * v0[2] + v0[3] * v0[3]) + (v1[0] * v1[0] + v1[1] * v1[1]) + (v1[2] * v1[2] + v1[3] * v1[3]);
                        *(u32x4*)(HA + (size_t)row * 512 + lc) = pack8(v0, v1); }
                    ss += shx(ss, 16, fq * 16 + fr); ss += shx(ss, 32, fq * 16 + fr);
                    if (fq == 0) SSQ[(size_t)row * 8 + wc] = ss;
                } else if (pn == 1) {
                    { const f32x4 v0 = acc[ai][0][m][0], v1 = acc[ai][0][m][1]; const int lc = wc * 32 + fq * 8;
                      float ss = (v0[0] * v0[0] + v0[1] * v0[1]) + (v0[2] * v0[2] + v0[3] * v0[3]) + (v1[0] * v1[0] + v1[1] * v1[1]) + (v1[2] * v1[2] + v1[3] * v1[3]);
                      *(u32x4*)(HA + (size_t)row * 512 + 256 + lc) = pack8(v0, v1);
                      ss += shx(ss, 16, fq * 16 + fr); ss += shx(ss, 32, fq * 16 + fr);
                      if (fq == 0) SSQ[(size_t)row * 8 + 4 + wc] = ss; }
                    { f32x4 v0 = acc[ai][1][m][0], v1 = acc[ai][1][m][1]; const int lc = HALF + wc * 32 + fq * 8;
                      *(u32x4*)(HA + (size_t)row * 512 + 256 + lc) = pack8(v0, v1);
                      if (wc == 0) {
                          const int pos = row & (SEQ - 1); const f32x4* cs = (const f32x4*)(tabM + ((size_t)pos * 16 + 4 * fq) * 2);
                          rope8(v0, v1, cs[0], cs[1]);
                          const u32x4 w = pack8(v0, v1);
#pragma unroll
                          for (int h = 0; h < 8; ++h) *(u32x4*)(KM + (size_t)row * 768 + h * 96 + 64 + fq * 8) = w;
                      } else if (wc == 1 && fq == 0) {
                          const int b = row >> 12, t = row & (SEQ - 1);
#pragma unroll
                          for (int h = 0; h < 4; ++h) { LOGF[((size_t)b * 8 + h) * SEQ + t] = logsigmoid_f(v0[h] + b_f[h]); LOGF[((size_t)b * 8 + 4 + h) * SEQ + t] = logsigmoid_f(v1[h] + b_f[4 + h]); }
                      } }
                } else {
#pragma unroll
                    for (int bj = 0; bj < 2; ++bj) { f32x4 v0 = acc[ai][bj][m][0], v1 = acc[ai][bj][m][1]; const int lc = bj * HALF + wc * 32 + fq * 8;
                        if (pn < 4) { v0 = v0 * SC_64; v1 = v1 * SC_64; *(u32x4*)(FQ + (size_t)row * 512 + (pn - 2) * 256 + lc) = pack8(v0, v1); }
                        else if (pn < 6) { *(u32x4*)(FK + (size_t)row * 512 + (pn - 4) * 256 + lc) = pack8(v0, v1); }
                        else if (pn < 8) { *(u32x4*)(FV + (size_t)row * 512 + (pn - 6) * 256 + lc) = pack8(v0, v1); }
                        else {
#pragma unroll
                            for (int e = 0; e < 4; ++e) { v0[e] = silu_f(v0[e]); v1[e] = silu_f(v1[e]); }
                            *(u32x4*)(G + (size_t)row * 1024 + (pn - 8) * 256 + lc) = pack8(v0, v1); } }
                }
                asm volatile("" ::: "memory");
            }
    }
};

struct EpiUp {
    static constexpr bool PERM = true, AFTER_DRAIN = false;
    bf16_t *QM, *KM, *VM; const float* SSQ; const float* tabM;
    __device__ __forceinline__ void operator()(AccT acc, const Unit& u, int wr, int wc, int fr, int fq) const {
        const int pn = u.pn;
#pragma unroll
        for (int ai = 0; ai < 2; ++ai)
#pragma unroll
            for (int m = 0; m < 4; ++m) {
                const int row = u.pm * BM + ai * HALF + wr * 64 + m * 16 + fr;
                const f32x4 s0 = *(const f32x4*)(SSQ + (size_t)row * 8 + (pn < 3 ? 0 : 4)); const f32x4 s1 = s0;
                if (pn < 3) {
                    const float rq = (1.0f / sqrtf(((s0[0] + s0[1]) + (s0[2] + s0[3])) * (1.0f / 256.0f) + RMS_EPS)) * SC_MLA;
#pragma unroll
                    for (int bj = 0; bj < 2; ++bj) { f32x4 v0 = acc[ai][bj][m][0] * rq, v1 = acc[ai][bj][m][1] * rq; const int gc = pn * 256 + bj * HALF + wc * 32 + fq * 8;
                        const int p = gc % 96;
                        if (p >= 64) { const int pos = row & (SEQ - 1); const f32x4* cs = (const f32x4*)(tabM + ((size_t)pos * 16 + ((p - 64) >> 1)) * 2); rope8(v0, v1, cs[0], cs[1]); }
                        *(u32x4*)(QM + (size_t)row * 768 + gc) = pack8(v0, v1); }
                } else {
                    const float rk = 1.0f / sqrtf(((s1[0] + s1[1]) + (s1[2] + s1[3])) * (1.0f / 128.0f) + RMS_EPS);
#pragma unroll
                    for (int bj = 0; bj < 2; ++bj) { const f32x4 v0 = acc[ai][bj][m][0] * rk, v1 = acc[ai][bj][m][1] * rk; const int gc = (pn - 3) * 256 + bj * HALF + wc * 32 + fq * 8;
                        const int head = gc >> 7, e = gc & 127;
                        if (e < 64) *(u32x4*)(KM + (size_t)row * 768 + head * 96 + e) = pack8(v0, v1);
                        else *(u32x4*)(VM + (size_t)row * 512 + head * 64 + (e - 64)) = pack8(v0, v1); }
                }
                asm volatile("" ::: "memory");
            }
    }
};

struct EpiOddIn {
    static constexpr bool PERM = true, AFTER_DRAIN = false;
    bf16_t *QS, *KS, *VS, *G; const float* tabS;
    __device__ __forceinline__ void operator()(AccT acc, const Unit& u, int wr, int wc, int fr, int fq) const {
        const int pn = u.pn;
#pragma unroll
        for (int ai = 0; ai < 2; ++ai)
#pragma unroll
            for (int m = 0; m < 4; ++m) {
                const int row = u.pm * BM + ai * HALF + wr * 64 + m * 16 + fr; const int pos = row & (SEQ - 1);
#pragma unroll
                for (int bj = 0; bj < 2; ++bj) { f32x4 v0 = acc[ai][bj][m][0], v1 = acc[ai][bj][m][1]; const int lc = bj * HALF + wc * 32 + fq * 8;
                    if (pn < 4) { const f32x4* cs = (const f32x4*)(tabS + ((size_t)pos * 32 + ((lc & 63) >> 1)) * 2); rope8(v0, v1, cs[0], cs[1]);
                        v0 = v0 * SC_64; v1 = v1 * SC_64; *(u32x4*)(QS + (size_t)row * 1024 + pn * 256 + lc) = pack8(v0, v1); }
                    else if (pn == 4) {
                        if (bj == 0) { const f32x4* cs = (const f32x4*)(tabS + ((size_t)pos * 32 + ((lc & 63) >> 1)) * 2); rope8(v0, v1, cs[0], cs[1]); *(u32x4*)(KS + (size_t)row * 128 + lc) = pack8(v0, v1); }
                        else *(u32x4*)(VS + (size_t)row * 128 + (lc - HALF)) = pack8(v0, v1); }
                    else {
#pragma unroll
                        for (int e = 0; e < 4; ++e) { v0[e] = silu_f(v0[e]); v1[e] = silu_f(v1[e]); }
                        *(u32x4*)(G + (size_t)row * 1024 + (pn - 5) * 256 + lc) = pack8(v0, v1); } }
                asm volatile("" ::: "memory");
            }
    }
};

struct EpiResid {
    static constexpr bool PERM = false, AFTER_DRAIN = false;
    const float* base; float* out;
    __device__ __forceinline__ void operator()(AccT acc, const Unit& u, int wr, int wc, int fr, int fq) const {
#pragma unroll
        for (int ai = 0; ai < 2; ++ai)
#pragma unroll
            for (int m = 0; m < 4; ++m) { const size_t off = (size_t)(u.pm * BM + ai * HALF + wr * 64 + m * 16 + fr) * DMODEL + u.pn * BM + wc * 32 + 4 * fq;
#pragma unroll
                for (int bj = 0; bj < 2; ++bj)
#pragma unroll
                    for (int n = 0; n < 2; ++n) { const f32x4 bs = *(const f32x4*)(base + off + bj * HALF + n * 16); *(f32x4*)(out + off + bj * HALF + n * 16) = bs * ALPHA + acc[ai][bj][m][n]; } }
    }
};
}

namespace att {
constexpr int KBUF = 12288, VBUF = 8192, BBUF = 256, BUFSZ = KBUF + VBUF + BBUF;
constexpr int OFF_WS = 2 * BUFSZ, OFF_OST = OFF_WS + NWAVES * 256, LDS_TOTAL = OFF_OST + NWAVES * 4096;
static_assert(LDS_TOTAL <= RING_BYTES, "attention LDS");
__device__ __forceinline__ int crow(int r, int hi) { return (r & 3) + 8 * (r >> 2) + 4 * hi; }
__device__ __forceinline__ s16x4 vtr(const LAS unsigned char* p) { typedef short v4i16_t __attribute__((ext_vector_type(4))); return __builtin_bit_cast(s16x4, __builtin_amdgcn_ds_read_tr16_b64_v4i16((LAS v4i16_t*)p)); }

template <int DK, int MODE>
__device__ __forceinline__ void attn_unit(LAS unsigned char* lds, const bf16_t* Qb, int ldq, const bf16_t* Kb, int ldk, const bf16_t* Vb, int ldv, bf16_t* Gb, int ldg,
                                          const float* cum, float sink2, int q0) {
    int tid_ = threadIdx.x; asm volatile("" : "+v"(tid_));
    const int tid = tid_, lane = tid & 63, wid = __builtin_amdgcn_readfirstlane(tid >> 6), r32 = lane & 31, hi = lane >> 5;
    const int qw = q0 + 32 * wid;
    bf16x8 qr[DK / 16];
#pragma unroll
    for (int d0 = 0; d0 < DK / 16; ++d0) qr[d0] = *(const bf16x8*)(Qb + (size_t)(qw + r32) * ldq + d0 * 16 + hi * 8);
    float ct2 = 0.f; if (MODE == 1) ct2 = cum[qw + r32];
    const int kbeg = (MODE == 2) ? (q0 >= 128 ? q0 - 128 : 0) : 0, kend = q0 + 256, nt = (kend - kbeg) >> 6;
    LAS float* wsf = (LAS float*)(lds + OFF_WS) + wid * 64;
    u32x4 kst0, kst1 = (u32x4){0u, 0u, 0u, 0u}, vst; float bst = 0.f;
#define ATT_ISSUE(k0_) do { const int k0i = (k0_); \
        kst0 = *(const u32x4*)(Kb + (size_t)(k0i + lane) * ldk + wid * 8); \
        if (DK == 96 && wid < 4) kst1 = *(const u32x4*)(Kb + (size_t)(k0i + lane) * ldk + (8 + wid) * 8); \
        vst = *(const u32x4*)(Vb + (size_t)(k0i + (tid >> 3)) * ldv + ((tid >> 2) & 1) * 32 + (tid & 3) * 8); \
        if (MODE == 1 && tid < 64) bst = cum[k0i + tid]; } while (0)
#define ATT_COMMIT(bo_) do { const int boi = (bo_); \
        *(LAS u32x4*)(lds + boi + wid * 1024 + lane * 16) = kst0; \
        if (DK == 96 && wid < 4) *(LAS u32x4*)(lds + boi + (8 + wid) * 1024 + lane * 16) = kst1; \
        *(LAS u32x4*)(lds + boi + KBUF + ((tid >> 2) & 1) * 4096 + (tid >> 3) * 64 + (tid & 3) * 16) = vst; \
        if (MODE == 1 && tid < 64) *(LAS float*)(lds + boi + KBUF + VBUF + tid * 4) = bst; } while (0)
    float mhat = -64.f, lsum = 0.f; f32x16 o0 = f32x16{}, o1 = f32x16{};
    ATT_ISSUE(kbeg); ATT_COMMIT(0); __syncthreads();
    const int vaddr = ((lane >> 4) & 1) * 32 + (lane & 3) * 8 + (4 * hi + ((lane & 15) >> 2)) * 64;
    for (int t = 0; t < nt; ++t) {
        const int cur = (t & 1) * BUFSZ, k0 = kbeg + 64 * t;
        if (t + 1 < nt) ATT_ISSUE(k0 + 64);
        const bool need = (MODE == 2) ? (k0 + 63 >= qw - 127 && k0 <= qw + 31) : (k0 <= qw + 31);
        if (need) {
            f32x16 p0, p1; const float ci = ct2 - mhat;
#pragma unroll
            for (int r = 0; r < 16; ++r) { p0[r] = ci; p1[r] = ci; }
#pragma unroll
            for (int d0 = 0; d0 < DK / 16; ++d0) {
                const bf16x8 b0 = *(const LAS bf16x8*)(lds + cur + (2 * d0 + hi) * 1024 + r32 * 16);
                const bf16x8 b1 = *(const LAS bf16x8*)(lds + cur + (2 * d0 + hi) * 1024 + 512 + r32 * 16);
                p0 = __builtin_amdgcn_mfma_f32_32x32x16_bf16(b0, qr[d0], p0, 0, 0, 0);
                p1 = __builtin_amdgcn_mfma_f32_32x32x16_bf16(b1, qr[d0], p1, 0, 0, 0);
            }
            if (MODE == 1) {
#pragma unroll
                for (int g = 0; g < 4; ++g) { const f32x4 c0 = *(const LAS f32x4*)(lds + cur + KBUF + VBUF + (8 * g + 4 * hi) * 4), c1 = *(const LAS f32x4*)(lds + cur + KBUF + VBUF + (32 + 8 * g + 4 * hi) * 4);
#pragma unroll
                    for (int e = 0; e < 4; ++e) { p0[4 * g + e] -= c0[e]; p1[4 * g + e] -= c1[e]; } }
            }
            if (MODE == 2 || k0 + 63 > qw) {
                const int q = qw + r32;
#pragma unroll
                for (int r = 0; r < 16; ++r) { const int kv = k0 + crow(r, hi);
                    const bool bad0 = (kv > q) || (MODE == 2 && q - kv >= 128), bad1 = (kv + 32 > q) || (MODE == 2 && q - (kv + 32) >= 128);
                    p0[r] = bad0 ? -INFINITY : p0[r]; p1[r] = bad1 ? -INFINITY : p1[r]; }
            }
            float rm = fmaxf(p0[0], p1[0]);
#pragma unroll
            for (int r = 1; r < 16; ++r) rm = fmaxf(rm, fmaxf(p0[r], p1[r]));
            rm = swap32_max(rm);
            if (__any(rm > 8.0f)) {
                const float dl = fmaxf(rm, 0.f); mhat += dl;
#pragma unroll
                for (int r = 0; r < 16; ++r) { p0[r] -= dl; p1[r] -= dl; }
                const float f = __builtin_amdgcn_exp2f(-dl); lsum *= f;
                if (hi == 0) wsf[r32] = f;
                LDS_WAIT();
#pragma unroll
                for (int g = 0; g < 4; ++g) { const f32x4 fv = *(const LAS f32x4*)(wsf + 8 * g + 4 * hi);
#pragma unroll
                    for (int e = 0; e < 4; ++e) { o0[4 * g + e] *= fv[e]; o1[4 * g + e] *= fv[e]; } }
            }
            float sacc = 0.f;
#pragma unroll
            for (int r = 0; r < 16; ++r) { p0[r] = __builtin_amdgcn_exp2f(p0[r]); p1[r] = __builtin_amdgcn_exp2f(p1[r]); sacc += p0[r] + p1[r]; }
            lsum += sacc;
            u32x4 pw[4];
#pragma unroll
            for (int e = 0; e < 4; ++e) { pw[0][e] = cvt_pk_bf16(p0[2 * e], p0[2 * e + 1]); pw[1][e] = cvt_pk_bf16(p0[8 + 2 * e], p0[8 + 2 * e + 1]);
                                          pw[2][e] = cvt_pk_bf16(p1[2 * e], p1[2 * e + 1]); pw[3][e] = cvt_pk_bf16(p1[8 + 2 * e], p1[8 + 2 * e + 1]); }
            const LAS unsigned char* vb = lds + cur + KBUF + vaddr;
#pragma unroll
            for (int s = 0; s < 4; ++s) {
                const s16x4 l0 = vtr(vb + s * 1024), h0 = vtr(vb + s * 1024 + 512), l1 = vtr(vb + 4096 + s * 1024), h1 = vtr(vb + 4096 + s * 1024 + 512);
                const bf16x8 vf0 = (bf16x8){l0[0], l0[1], l0[2], l0[3], h0[0], h0[1], h0[2], h0[3]}, vf1 = (bf16x8){l1[0], l1[1], l1[2], l1[3], h1[0], h1[1], h1[2], h1[3]};
                const bf16x8 pa = __builtin_bit_cast(bf16x8, pw[s]);
                o0 = __builtin_amdgcn_mfma_f32_32x32x16_bf16(pa, vf0, o0, 0, 0, 0);
                o1 = __builtin_amdgcn_mfma_f32_32x32x16_bf16(pa, vf1, o1, 0, 0, 0);
            }
        }
        if (t + 1 < nt) ATT_COMMIT(cur == 0 ? BUFSZ : 0);
        __syncthreads();
    }
    lsum = swap32_add(lsum);
    if (MODE == 2) lsum += __builtin_amdgcn_exp2f(sink2 - mhat);
    if (hi == 0) wsf[32 + r32] = lsum;
    LDS_WAIT();
    LAS bf16_t* stg = (LAS bf16_t*)(lds + OFF_OST) + wid * 2048;
#pragma unroll
    for (int g = 0; g < 4; ++g) { const f32x4 lv = *(const LAS f32x4*)(wsf + 32 + 8 * g + 4 * hi);
#pragma unroll
        for (int e = 0; e < 4; ++e) { const float rl = 1.0f / lv[e]; const int orow = 8 * g + 4 * hi + e;
            stg[orow * 64 + r32] = (bf16_t)(cvt_pk_bf16(o0[4 * g + e] * rl, 0.f) & 0xffffu); stg[orow * 64 + 32 + r32] = (bf16_t)(cvt_pk_bf16(o1[4 * g + e] * rl, 0.f) & 0xffffu); } }
    LDS_WAIT();
#pragma unroll
    for (int i = 0; i < 4; ++i) { const int row = i * 8 + (lane >> 3), ch = lane & 7;
        const u32x4 ov = *(const LAS u32x4*)(stg + row * 64 + ch * 8);
        bf16_t* gp = Gb + (size_t)(qw + row) * ldg + ch * 8; const u32x4 gv = *(const u32x4*)gp; u32x4 w;
#pragma unroll
        for (int e = 0; e < 4; ++e) w[e] = cvt_pk_bf16(bf_lo(ov[e]) * bf_lo(gv[e]), bf_hi(ov[e]) * bf_hi(gv[e]));
        *(u32x4*)gp = w; }
    LDS_WAIT();
    __syncthreads();
#undef ATT_ISSUE
#undef ATT_COMMIT
}
}

#define XB_TMO      128
#define XB_XCNT(j)  (256  + 64 * (j))
#define XB_XSUB(j)  (1280 + 64 * (j))
#define XB_XGEN(j)  (2304 + 64 * (j))
#define XB_TOP      3328
#define XB_TOPGEN   3392
#define XCD_BAR_WORDS 3456
#define XB_SPIN_CAP (1u << 18)
__device__ __forceinline__ unsigned xb_ld(unsigned* p)              { return __hip_atomic_load(p, __ATOMIC_RELAXED, __HIP_MEMORY_SCOPE_AGENT); }
__device__ __forceinline__ unsigned xb_add(unsigned* p, unsigned v) { return __hip_atomic_fetch_add(p, v, __ATOMIC_RELAXED, __HIP_MEMORY_SCOPE_AGENT); }
__device__ __forceinline__ unsigned xb_xcc_id() { return (unsigned)__builtin_amdgcn_s_getreg((3 << 11) | 20) & 0xFu; }
#define XB_SPIN(cond, bar) do { unsigned _sp = 0; while (cond) { __builtin_amdgcn_s_sleep(1); \
    if ((++_sp & 255u) == 0u) { if (xb_ld(&(bar)[XB_TMO])) break; if (_sp > XB_SPIN_CAP) { atomicAdd(&(bar)[XB_TMO], 1u); break; } } } } while (0)
struct XcdBarrier { unsigned* bar; unsigned x; volatile LAS unsigned* st; };
__device__ __forceinline__ XcdBarrier xcd_barrier_post(unsigned* bar, volatile LAS unsigned* st) {
    XcdBarrier b; b.bar = bar; b.x = xb_xcc_id(); b.st = st;
    if (threadIdx.x == 0) (void)xb_add(&bar[XB_XCNT(b.x)], 1u);
    return b;
}
__device__ __forceinline__ void xcd_barrier_complete(unsigned* bar, unsigned x, unsigned& nloc, unsigned& nx) {
    const unsigned G = gridDim.x * gridDim.y * gridDim.z;
    unsigned sum, cnt, mine, sp = 0u;
    for (;;) {
        sum = 0u; cnt = 0u; mine = 0u;
#pragma unroll
        for (unsigned j = 0; j < 16; ++j) { const unsigned c = xb_ld(&bar[XB_XCNT(j)]); sum += c; cnt += (c > 0u) ? 1u : 0u; mine = (j == x) ? c : mine; }
        if (sum == G) break;
        __builtin_amdgcn_s_sleep(1);
        if ((++sp & 255u) == 0u) { if (xb_ld(&bar[XB_TMO])) break; if (sp > XB_SPIN_CAP) { atomicAdd(&bar[XB_TMO], 1u); break; } }
    }
    nloc = mine > 0u ? mine : 1u; nx = cnt > 0u ? cnt : 1u;
}
__device__ __forceinline__ void xcd_barrier(const XcdBarrier& b) {
    asm volatile("s_waitcnt vmcnt(0)" ::: "memory");
    __syncthreads();
    if (threadIdx.x == 0) {
        unsigned* bar = b.bar;
        __builtin_amdgcn_s_waitcnt(0);
        unsigned nloc = b.st[0], nx = b.st[1];
        if (nloc == 0u) { xcd_barrier_complete(bar, b.x, nloc, nx); b.st[0] = nloc; b.st[1] = nx; }
        const unsigned old = xb_add(&bar[XB_XSUB(b.x)], 1u);
        const unsigned gen = old / nloc;
        if (old + 1u == (gen + 1u) * nloc) {
            __builtin_amdgcn_fence(__ATOMIC_RELEASE, "agent");
            asm volatile("s_waitcnt vmcnt(0)" ::: "memory");
            const unsigned og = xb_add(&bar[XB_TOP], 1u);
            const unsigned tg = og / nx;
            if (og + 1u == (tg + 1u) * nx) xb_add(&bar[XB_TOPGEN], 1u);
            else XB_SPIN(xb_ld(&bar[XB_TOPGEN]) == tg, bar);
            __builtin_amdgcn_fence(__ATOMIC_ACQUIRE, "agent");
            xb_add(&bar[XB_XGEN(b.x)], 1u);
            asm volatile("s_waitcnt vmcnt(0)" ::: "memory");
        } else {
            XB_SPIN(xb_ld(&bar[XB_XGEN(b.x)]) == gen, bar);
            __builtin_amdgcn_fence(__ATOMIC_ACQUIRE, "agent");
            asm volatile("s_waitcnt vmcnt(0)" ::: "memory");
        }
    }
    __syncthreads();
}

struct Args { const float* in[15]; float* out; unsigned char* ws; int ph_lo, ph_hi; };

struct Frame {
    LAS unsigned char* lds; int tid, lane, wave, vcu, G; unsigned char* ws;
};

__device__ __forceinline__ float wave_sum(float v, int lane) {
#pragma unroll
    for (int o = 1; o < 64; o <<= 1) v += shx(v, o, lane);
    return v;
}

__device__ __forceinline__ int srccol(int kind, int n) {
    if (kind == 1) {
        if (n < 384) return n;
        if (n < 416) { const int p = n - 384; return 384 + (p >> 1) + 16 * (p & 1); }
        if (n < 424) return 1952 + (n - 416);
        if (n < 512) return -1;
        if (n < 2048) return 416 + (n - 512);
        return 1960 + (n - 2048);
    }
    if (kind == 2) { const int h = n / 96, p = n % 96; if (p < 64) return n; const int pp = p - 64; return h * 96 + 64 + (pp >> 1) + 16 * (pp & 1); }
    if (kind == 3) { if (n < 1152) { const int h = n >> 6, p = n & 63; return (h << 6) + (p >> 1) + 32 * (p & 1); } return n; }
    return n;
}
__device__ __forceinline__ void transpose_item(const float* W, int ldw, int Ksrc, const float* gain, bf16_t* WT, int Kdst, int kind, int k0, int n0, LAS float* scr, int lane) {
    const int nl = lane & 31, src = srccol(kind, n0 + nl);
#pragma unroll 8
    for (int i = 0; i < 32; ++i) { const int kk = 2 * i + (lane >> 5), k = k0 + kk; float v = 0.f;
        if (src >= 0 && k < Ksrc) { v = W[(size_t)k * ldw + src]; if (gain) v *= gain[k]; }
        scr[kk * 33 + nl] = v; }
    LDS_WAIT(); asm volatile("" ::: "memory");
    const int c = lane & 7;
#pragma unroll
    for (int j = 0; j < 4; ++j) { const int n = (lane >> 3) + 8 * j; const LAS float* s = scr + (8 * c) * 33 + n;
        u32x4 o; o.x = cvt_pk_bf16(s[0 * 33], s[1 * 33]); o.y = cvt_pk_bf16(s[2 * 33], s[3 * 33]); o.z = cvt_pk_bf16(s[4 * 33], s[5 * 33]); o.w = cvt_pk_bf16(s[6 * 33], s[7 * 33]);
        *(u32x4*)(WT + (size_t)(n0 + n) * Kdst + k0 + 8 * c) = o; }
    LDS_WAIT(); asm volatile("" ::: "memory");
}

__device__ __forceinline__ void p0_prologue(Frame& F, const Args& a) {
    LAS float* scr = (LAS float*)(F.lds + F.wave * 16384);
    const int gw = F.vcu * NWAVES + F.wave, NGW = F.G * NWAVES;
    constexpr int IA = 16 * 96, IB = 4 * 24, IC = 4 * 32, ID = 16 * 32, IE = 16 * 72, IF_ = 16 * 32, IL = IA + IB + IC + ID + IE + IF_;
    for (int it = gw; it < 2 * IL; it += NGW) {
        const int j = it / IL; int r = it % IL; unsigned char* wl = F.ws + WS_W + (size_t)j * W_LAYER;
        if (r < IA) { transpose_item(a.in[1] + (size_t)j * DMODEL * EVEN_IN, EVEN_IN, DMODEL, nullptr, (bf16_t*)(wl + W_INE), DMODEL, 1, 64 * (r / 96), 32 * (r % 96), scr, F.lane); continue; } r -= IA;
        if (r < IB) { transpose_item(a.in[3] + (size_t)j * 256 * 768, 768, 256, a.in[2] + j * 256, (bf16_t*)(wl + W_UP), 256, 2, 64 * (r / 24), 32 * (r % 24), scr, F.lane); continue; } r -= IB;
        if (r < IC) { transpose_item(a.in[5] + (size_t)j * 128 * 1024, 1024, 128, a.in[4] + j * 128, (bf16_t*)(wl + W_UP) + 768 * 256, 256, 0, 64 * (r / 32), 32 * (r % 32), scr, F.lane); continue; } r -= IC;
        if (r < ID) { transpose_item(a.in[7] + (size_t)j * DMODEL * DMODEL, DMODEL, DMODEL, nullptr, (bf16_t*)(wl + W_OUTE), DMODEL, 0, 64 * (r / 32), 32 * (r % 32), scr, F.lane); continue; } r -= ID;
        if (r < IE) { transpose_item(a.in[10] + (size_t)j * DMODEL * ODD_IN, ODD_IN, DMODEL, nullptr, (bf16_t*)(wl + W_INO), DMODEL, 3, 64 * (r / 72), 32 * (r % 72), scr, F.lane); continue; } r -= IE;
        transpose_item(a.in[12] + (size_t)j * DMODEL * DMODEL, DMODEL, DMODEL, nullptr, (bf16_t*)(wl + W_OUTO), DMODEL, 0, 64 * (r / 32), 32 * (r % 32), scr, F.lane);
    }
    bf16_t* XB = (bf16_t*)(F.ws + WS_XB);
    for (int m = gw; m < MTOK; m += NGW) { const f32x4* xr = (const f32x4*)(a.in[0] + (size_t)m * DMODEL) + F.lane; u32x2* o8 = (u32x2*)(XB + (size_t)m * DMODEL) + F.lane;
#pragma unroll
        for (int j = 0; j < 4; ++j) { const f32x4 v = xr[64 * j]; u32x2 w; w.x = cvt_pk_bf16(v[0], v[1]); w.y = cvt_pk_bf16(v[2], v[3]); o8[64 * j] = w; } }
    float* tabS = (float*)(F.ws + WS_TABS); float* tabM = (float*)(F.ws + WS_TABM);
    const int gt = (F.vcu * NWAVES + F.wave) * 64 + F.lane, NT = F.G * NWAVES * 64;
    for (int idx = gt; idx < SEQ * 32 + SEQ * 16; idx += NT) {
        if (idx < SEQ * 32) { const int pos = idx >> 5, i = idx & 31; const float inv = powf(10000.0f, -(float)(2 * i) / 64.0f); const float ang = (float)pos * inv; tabS[2 * idx] = cosf(ang); tabS[2 * idx + 1] = sinf(ang); }
        else { const int jx = idx - SEQ * 32; const int pos = jx >> 4, i = jx & 15; const float inv = powf(10000.0f, -(float)(2 * i) / 32.0f); const float ang = (float)pos * inv; tabM[2 * jx] = cosf(ang); tabM[2 * jx + 1] = sinf(ang); }
    }
}

__device__ __forceinline__ void scan_seq(const float* src, float* dst, int lane) {
    asm volatile("" : "+v"(lane));
    float carry = 0.f;
    for (int j = 0; j < SEQ / 256; ++j) {
        f32x4 v = *(const f32x4*)(src + j * 256 + lane * 4);
        v[1] += v[0]; v[2] += v[1]; v[3] += v[2];
        const float tot = v[3]; float inc = tot;
#pragma unroll
        for (int o = 1; o < 64; o <<= 1) { const float t = __int_as_float(__builtin_amdgcn_ds_bpermute((lane - o) << 2, __float_as_int(inc))); if (lane >= o) inc += t; }
        const float ex = inc - tot + carry;
        f32x4 w; w[0] = (v[0] + ex) * LOG2E; w[1] = (v[1] + ex) * LOG2E; w[2] = (v[2] + ex) * LOG2E; w[3] = (v[3] + ex) * LOG2E;
        *(f32x4*)(dst + j * 256 + lane * 4) = w;
        carry += __int_as_float(__builtin_amdgcn_readlane(__float_as_int(inc), 63));
    }
}

__device__ __forceinline__ void ln_rows(Frame& F, float* z, const float* g, const float* b, bf16_t* XB) {
    const int gw = F.vcu * NWAVES + F.wave, NGW = F.G * NWAVES;
    int lane_ = F.lane; asm volatile("" : "+v"(lane_));
    f32x4 gv[4], bv[4];
#pragma unroll
    for (int j = 0; j < 4; ++j) { gv[j] = ((const f32x4*)g)[lane_ + 64 * j]; bv[j] = ((const f32x4*)b)[lane_ + 64 * j]; }
    for (int m = gw; m < MTOK; m += NGW) {
        f32x4* xr = (f32x4*)(z + (size_t)m * DMODEL) + lane_; f32x4 v[4]; float s = 0.f;
#pragma unroll
        for (int j = 0; j < 4; ++j) { v[j] = xr[64 * j]; s += (v[j][0] + v[j][1]) + (v[j][2] + v[j][3]); }
        const float mean = wave_sum(s, lane_) * (1.f / DMODEL); float s2 = 0.f;
#pragma unroll
        for (int j = 0; j < 4; ++j) { v[j] = v[j] - mean; s2 += (v[j][0] * v[j][0] + v[j][1] * v[j][1]) + (v[j][2] * v[j][2] + v[j][3] * v[j][3]); }
        const float rstd = 1.f / sqrtf(wave_sum(s2, lane_) * (1.f / DMODEL) + LN_EPS);
        u32x2* o8 = (u32x2*)(XB + (size_t)m * DMODEL) + lane_;
#pragma unroll
        for (int j = 0; j < 4; ++j) { const f32x4 y = v[j] * rstd * gv[j] + bv[j]; xr[64 * j] = y; u32x2 w; w.x = cvt_pk_bf16(y[0], y[1]); w.y = cvt_pk_bf16(y[2], y[3]); o8[64 * j] = w; }
    }
}

constexpr int N_PHASES = 19;
__global__ void __launch_bounds__(NWAVES * 64, 2) fwd(Args args) {
    extern __shared__ __attribute__((aligned(16))) unsigned char lds_raw[];
    Frame F;
    F.lds = (LAS unsigned char*)lds_raw; F.tid = threadIdx.x; F.lane = F.tid & 63; F.wave = __builtin_amdgcn_readfirstlane(F.tid >> 6);
    F.G = gridDim.x; { const int bx = blockIdx.x; F.vcu = (F.G % 8 == 0) ? (bx % 8) * (F.G / 8) + bx / 8 : bx; }
    F.ws = args.ws;
    unsigned char* ws = args.ws;
    const int lo = args.ph_lo, hi = args.ph_hi;
    volatile LAS unsigned* bst = (volatile LAS unsigned*)(F.lds + RING_BYTES + 64);
    if (F.tid < 2) bst[F.tid] = 0u;
    __syncthreads();
    XcdBarrier gbar; gbar.bar = (unsigned*)(ws + WS_CTL) + 4096; gbar.x = 0; gbar.st = bst;
    if (hi - lo > 1) gbar = xcd_barrier_post((unsigned*)(ws + WS_CTL) + 4096, bst);
#ifndef PHM
#define PHM 0xFFFF
#endif
#define RUN(k) (lo <= (k) && (k) < hi)
#define SEAM(k) do { if (RUN(k) && RUN((k) + 1)) { xcd_barrier(gbar); } } while (0)
    bf16_t* XB = (bf16_t*)(ws + WS_XB); bf16_t* G = (bf16_t*)(ws + WS_G);
    float* tabS = (float*)(ws + WS_TABS); float* tabM = (float*)(ws + WS_TABM);

    if ((PHM & 1) && RUN(0)) { p0_prologue(F, args); }
    SEAM(0);
    for (int L = 0; L < DEPTH; ++L) {
        const int j = L >> 1, pb = 1 + 9 * (L >> 1) + 5 * (L & 1);
        unsigned char* wl = ws + WS_W + (size_t)j * W_LAYER;
        const float* xbase = (L == 0) ? args.in[0] : args.out;
        if ((L & 1) == 0) {
            if ((PHM & 2) && RUN(pb)) {
                pg8::Gemm g{XB, (const bf16_t*)(wl + W_INE), MTOK, EVEN_INP, DMODEL, DMODEL, 1 << 30, 0}; pg8::StaticOrder S; S.init(MTOK, EVEN_INP, F.G, (int)blockIdx.x);
                pg8::EpiEvenIn E{(bf16_t*)(ws + WS_HA), (bf16_t*)(ws + WS_KM), (bf16_t*)(ws + WS_FQ), (bf16_t*)(ws + WS_FK), (bf16_t*)(ws + WS_FV), G, (float*)(ws + WS_SSQ), (float*)(ws + WS_LOGF), args.in[6] + j * 8, tabM};
                pg8::gemm_phase<pg8::EpiEvenIn, true>(F.lds, g, S, E);
            }
            SEAM(pb);
            if ((PHM & 4) && RUN(pb + 1)) {
                if (F.wave == 0) for (int sq = F.G - 1 - (int)blockIdx.x; sq < NBATCH * 8; sq += F.G) scan_seq((const float*)(ws + WS_LOGF) + (size_t)sq * SEQ, (float*)(ws + WS_CUM) + (size_t)sq * SEQ, F.lane);
                pg8::Gemm g{(const bf16_t*)(ws + WS_HA), (const bf16_t*)(wl + W_UP), MTOK, 1792, 256, 512, 3, 256}; pg8::StaticOrder S; S.init(MTOK, 1792, F.G, (int)blockIdx.x);
                pg8::EpiUp E{(bf16_t*)(ws + WS_QM), (bf16_t*)(ws + WS_KM), (bf16_t*)(ws + WS_VM), (const float*)(ws + WS_SSQ), tabM};
                pg8::gemm_phase<pg8::EpiUp, true>(F.lds, g, S, E);
            }
            SEAM(pb + 1);
            if ((PHM & 8) && RUN(pb + 2)) {
                for (int jj = F.vcu; jj < 1024; jj += F.G) {
                    const int i = jj >> 8, c = jj & 255, bh = c >> 3, s = c & 7, b = bh >> 3, h = bh & 7, qb = (i & 1) ? 15 - s : s;
                    const size_t r0 = (size_t)b * SEQ;
                    if (i < 2) att::attn_unit<96, 0>(F.lds, (const bf16_t*)(ws + WS_QM) + r0 * 768 + h * 96, 768, (const bf16_t*)(ws + WS_KM) + r0 * 768 + h * 96, 768,
                                                     (const bf16_t*)(ws + WS_VM) + r0 * 512 + h * 64, 512, G + r0 * 1024 + h * 64, 1024, nullptr, 0.f, qb * 256);
                    else att::attn_unit<64, 1>(F.lds, (const bf16_t*)(ws + WS_FQ) + r0 * 512 + h * 64, 512, (const bf16_t*)(ws + WS_FK) + r0 * 512 + h * 64, 512,
                                               (const bf16_t*)(ws + WS_FV) + r0 * 512 + h * 64, 512, G + r0 * 1024 + 512 + h * 64, 1024, (const float*)(ws + WS_CUM) + (size_t)bh * SEQ, 0.f, qb * 256);
                }
            }
            SEAM(pb + 2);
            if ((PHM & 16) && RUN(pb + 3)) {
                pg8::Gemm g{G, (const bf16_t*)(wl + W_OUTE), MTOK, DMODEL, DMODEL, DMODEL, 1 << 30, 0}; pg8::StaticOrder S; S.init(MTOK, DMODEL, F.G, (int)blockIdx.x);
                pg8::EpiResid E{xbase, args.out};
                pg8::gemm_phase<pg8::EpiResid, true>(F.lds, g, S, E);
            }
            SEAM(pb + 3);
            if ((PHM & 32) && RUN(pb + 4)) ln_rows(F, args.out, args.in[8] + j * DMODEL, args.in[9] + j * DMODEL, XB);
            SEAM(pb + 4);
        } else {
            if ((PHM & 64) && RUN(pb)) {
                pg8::Gemm g{XB, (const bf16_t*)(wl + W_INO), MTOK, ODD_IN, DMODEL, DMODEL, 1 << 30, 0}; pg8::StaticOrder S; S.init(MTOK, ODD_IN, F.G, (int)blockIdx.x);
                pg8::EpiOddIn E{(bf16_t*)(ws + WS_QS), (bf16_t*)(ws + WS_KS), (bf16_t*)(ws + WS_VS), G, tabS};
                pg8::gemm_phase<pg8::EpiOddIn, true>(F.lds, g, S, E);
            }
            SEAM(pb);
            if ((PHM & 128) && RUN(pb + 1)) {
                for (int jj = F.vcu; jj < 1024; jj += F.G) {
                    const int hq = jj & 7, qb = (jj >> 3) & 15, hk = (jj >> 7) & 1, b = jj >> 8, h = hk * 8 + hq;
                    const size_t r0 = (size_t)b * SEQ;
                    att::attn_unit<64, 2>(F.lds, (const bf16_t*)(ws + WS_QS) + r0 * 1024 + h * 64, 1024, (const bf16_t*)(ws + WS_KS) + r0 * 128 + hk * 64, 128,
                                          (const bf16_t*)(ws + WS_VS) + r0 * 128 + hk * 64, 128, G + r0 * 1024 + h * 64, 1024, nullptr, args.in[11][j * 16 + h] * LOG2E, qb * 256);
                }
            }
            SEAM(pb + 1);
            if ((PHM & 256) && RUN(pb + 2)) {
                pg8::Gemm g{G, (const bf16_t*)(wl + W_OUTO), MTOK, DMODEL, DMODEL, DMODEL, 1 << 30, 0}; pg8::StaticOrder S; S.init(MTOK, DMODEL, F.G, (int)blockIdx.x);
                pg8::EpiResid E{xbase, args.out};
                pg8::gemm_phase<pg8::EpiResid, true>(F.lds, g, S, E);
            }
            SEAM(pb + 2);
            if ((PHM & 512) && RUN(pb + 3)) ln_rows(F, args.out, args.in[13] + j * DMODEL, args.in[14] + j * DMODEL, XB);
            SEAM(pb + 3);
        }
    }
#undef RUN
#undef SEAM
}

extern "C" void kernel_launch(void* const* d_in, const int* in_sizes, int n_in, void* d_out, int out_size, void* d_ws, size_t ws_size, hipStream_t stream) {
    static int grid = 0;
    if (grid == 0) {
        if (n_in != 15 || in_sizes[0] != MTOK * DMODEL || out_size != MTOK * DMODEL || ws_size < WS_END) { fprintf(stderr, "kernel_launch: unexpected shapes (n_in %d, in0 %d, out %d, ws %zu)\n", n_in, n_in > 0 ? in_sizes[0] : -1, out_size, ws_size); grid = -1; return; }
        int dev = 0, cus = 0;
        if (hipGetDevice(&dev) != hipSuccess || hipDeviceGetAttribute(&cus, hipDeviceAttributeMultiprocessorCount, dev) != hipSuccess) { grid = -1; return; }
        if (hipFuncSetAttribute((const void*)fwd, hipFuncAttributeMaxDynamicSharedMemorySize, LDS_BYTES) != hipSuccess) { fprintf(stderr, "kernel_launch: hipFuncSetAttribute failed\n"); grid = -1; return; }
        grid = cus;
    }
    if (grid < 0) return;
    Args a{};
    for (int i = 0; i < 15; ++i) a.in[i] = (const float*)d_in[i];
    a.out = (float*)d_out; a.ws = (unsigned char*)d_ws;
    if (MK_N_LAUNCHES == 1) {
        if (hipMemsetAsync((char*)d_ws + WS_CTL, 0, CTL_ZERO_BYTES, stream) != hipSuccess) { fprintf(stderr, "kernel_launch: memset of the control words failed\n"); return; }
        a.ph_lo = 0; a.ph_hi = N_PHASES; void* kargs[] = {&a};
        const hipError_t e = hipLaunchCooperativeKernel((const void*)fwd, dim3(grid), dim3(NWAVES * 64), kargs, LDS_BYTES, stream);
        if (e != hipSuccess) fprintf(stderr, "kernel_launch: cooperative launch failed: %s (grid %d)\n", hipGetErrorString(e), grid);
    }
    else for (int p = 0; p < N_PHASES; ++p) { a.ph_lo = p; a.ph_hi = p + 1; hipLaunchKernelGGL(fwd, dim3(grid), dim3(NWAVES * 64), LDS_BYTES, stream, a); }
}
```
